# Optimizing an MI355X kernel written in HIP

```python
import math
import jax, jax.numpy as jnp
from jax import lax
import numpy as np

D_MODEL = 1024
BATCH = 16
SEQ = 4096
DEPTH = 1
DEC_BATCH = 8
DEC_SEQ = 64
PAST_LEN = 1024

CHUNK = 64
Q_BLOCK = 128
ROPE_THETA = 10000.0
NORM_EPS = 1e-6
NEG_INF = -1e30

MIX_WIDTH = D_MODEL
DIFF_HEADS = 4
DIFF_HEAD_DIM = 64
DIFF_WIDTH = DIFF_HEADS * 2 * DIFF_HEAD_DIM
MLA_HEADS = 4
MLA_Q_LORA = 256
MLA_KV_LORA = 128
MLA_NOPE = 128
MLA_ROPE = 64
MLA_V = 128
MLA_WIDTH = MLA_HEADS * MLA_V
MLA_SCALE = (MLA_NOPE + MLA_ROPE) ** -0.5
OFF_DQ = 0
OFF_DK = OFF_DQ + DIFF_WIDTH
OFF_DV = OFF_DK + DIFF_WIDTH
OFF_CQ = OFF_DV + DIFF_WIDTH
OFF_CKV = OFF_CQ + MLA_Q_LORA
OFF_KR = OFF_CKV + MLA_KV_LORA
IN_COLS = OFF_KR + MLA_ROPE
D_FF = 2816
CONV_W = 3

kernel_name = "hymba_diff_mla_convffn_stream_step"


def rmsnorm(x, g):
    xf = x.astype(jnp.float32)
    y = xf * lax.rsqrt(jnp.mean(xf * xf, axis=-1, keepdims=True) + NORM_EPS)
    return (y * g.astype(jnp.float32)).astype(x.dtype)


def rope(x, pos):
    dim = x.shape[-1]
    half = dim // 2
    inv = ROPE_THETA ** (-jnp.arange(half, dtype=jnp.float32) * (2.0 / dim))
    ang = pos.astype(jnp.float32)[:, None] * inv[None, :]
    shp = (ang.shape[0],) + (1,) * (x.ndim - 3) + (half,)
    cos = jnp.cos(ang).reshape(shp)
    sin = jnp.sin(ang).reshape(shp)
    xf = x.astype(jnp.float32)
    x1, x2 = xf[..., :half], xf[..., half:]
    return jnp.concatenate([x1 * cos - x2 * sin, x2 * cos + x1 * sin], axis=-1).astype(x.dtype)


def diff_attention(q, k, v, q_chunk, k_chunk, lam, lam_init, g_sub):
    s = jnp.einsum('bqhmd,bkhmd->bhmqk', q, k).astype(jnp.float32) * (DIFF_HEAD_DIM ** -0.5)
    vis = k_chunk[None, :] <= q_chunk[:, None]
    p = jax.nn.softmax(jnp.where(vis, s, NEG_INF), axis=-1)
    a = (p[:, :, 0] - lam * p[:, :, 1]).astype(v.dtype)
    o = jnp.einsum('bhqk,bkhe->bqhe', a, v)
    o = rmsnorm(o, g_sub) * (1.0 - lam_init)
    return o.reshape(o.shape[0], o.shape[1], DIFF_WIDTH)


def mla_attention(q_nope, q_rope, k_nope, k_rope, v, q_chunk, k_chunk):
    s = (jnp.einsum('bqhd,bkhd->bhqk', q_nope, k_nope)
         + jnp.einsum('bqhr,bkr->bhqk', q_rope, k_rope)).astype(jnp.float32) * MLA_SCALE
    vis = k_chunk[None, :] <= q_chunk[:, None]
    p = jax.nn.softmax(jnp.where(vis, s, NEG_INF), axis=-1)
    o = jnp.einsum('bhqk,bkhd->bqhd', p.astype(v.dtype), v)
    return o.reshape(o.shape[0], o.shape[1], MLA_WIDTH)


def over_query_blocks(fn, q_arrays, q_chunk):
    n_blk = q_chunk.shape[0] // Q_BLOCK

    def split(a):
        a = a.reshape((a.shape[0], n_blk, Q_BLOCK) + a.shape[2:])
        return jnp.moveaxis(a, 1, 0)

    xs = tuple(split(a) for a in q_arrays) + (q_chunk.reshape(n_blk, Q_BLOCK),)
    out = lax.map(lambda blk: fn(*blk), xs)
    out = jnp.moveaxis(out, 0, 1)
    return out.reshape(out.shape[0], n_blk * Q_BLOCK, out.shape[-1])


def hybrid_layer(x, pos, past, lam_init, g_attn, w_in, lq1, lk1, lq2, lk2, g_sub,
                 g_qa, w_qb, g_kva, w_kvb, w_out, g_ffn, w_up, w_conv, b_conv, w_down):
    B, T, _ = x.shape
    h = rmsnorm(x, g_attn)
    proj = h @ w_in
    q_d = rope(proj[..., OFF_DQ:OFF_DK].reshape(B, T, DIFF_HEADS, 2, DIFF_HEAD_DIM), pos)
    k_d = rope(proj[..., OFF_DK:OFF_DV].reshape(B, T, DIFF_HEADS, 2, DIFF_HEAD_DIM), pos)
    v_d = proj[..., OFF_DV:OFF_CQ].reshape(B, T, DIFF_HEADS, 2 * DIFF_HEAD_DIM)
    c_q = rmsnorm(proj[..., OFF_CQ:OFF_CKV], g_qa)
    c_kv = rmsnorm(proj[..., OFF_CKV:OFF_KR], g_kva)
    k_r = rope(proj[..., OFF_KR:IN_COLS], pos)
    q_m = (c_q @ w_qb).reshape(B, T, MLA_HEADS, MLA_NOPE + MLA_ROPE)
    q_nope = q_m[..., :MLA_NOPE]
    q_rope = rope(q_m[..., MLA_NOPE:], pos)

    if past is None:
        dk_all, dv_all, ckv_all, kr_all, k_pos = k_d, v_d, c_kv, k_r, pos
        conv_prev = jnp.zeros((B, CONV_W - 1, D_FF), x.dtype)
    else:
        p_dk, p_dv, p_ckv, p_kr, conv_prev = past
        P = p_dk.shape[1]
        dk_all = jnp.concatenate([p_dk, k_d], axis=1)
        dv_all = jnp.concatenate([p_dv, v_d], axis=1)
        ckv_all = jnp.concatenate([p_ckv, c_kv], axis=1)
        kr_all = jnp.concatenate([p_kr, k_r], axis=1)
        k_pos = jnp.concatenate([jnp.arange(P, dtype=jnp.int32), pos])
    Tk = ckv_all.shape[1]
    k_chunk = k_pos // CHUNK
    q_chunk = pos // CHUNK
    kv = (ckv_all @ w_kvb).reshape(B, Tk, MLA_HEADS, MLA_NOPE + MLA_V)
    k_nope, v_m = kv[..., :MLA_NOPE], kv[..., MLA_NOPE:]

    lam = (jnp.exp(jnp.sum(lq1.astype(jnp.float32) * lk1.astype(jnp.float32)))
           - jnp.exp(jnp.sum(lq2.astype(jnp.float32) * lk2.astype(jnp.float32))) + lam_init)

    def attend(qd, qn, qr, qc):
        od = diff_attention(qd, dk_all, dv_all, qc, k_chunk, lam, lam_init, g_sub)
        om = mla_attention(qn, qr, k_nope, kr_all, v_m, qc, k_chunk)
        return jnp.concatenate([od, om], axis=-1)

    if past is None:
        mix = over_query_blocks(attend, (q_d, q_nope, q_rope), q_chunk)
    else:
        mix = attend(q_d, q_nope, q_rope, q_chunk)
    x1 = x + mix @ w_out

    h2 = rmsnorm(x1, g_ffn)
    up = h2 @ w_up
    u, g = up[..., :D_FF], up[..., D_FF:]
    g_ext = jnp.concatenate([conv_prev, g], axis=1)
    conv = b_conv + sum(g_ext[:, j:j + T] * w_conv[j] for j in range(CONV_W))
    y = x1 + (jax.nn.silu(conv) * u) @ w_down
    new_conv = g_ext[:, -(CONV_W - 1):]
    return y, (k_d, v_d, c_kv, k_r, new_conv)


def setup_inputs(seed: int = 0) -> dict:
    key = jax.random.key(seed)
    ks = jax.random.split(key, 32)
    f32 = jnp.float32

    def nrm(k, shape, scale=1.0):
        return jax.random.normal(k, shape, f32) * scale

    def gain(k, shape):
        return 1.0 + 0.05 * jax.random.normal(k, shape, f32)

    return {
        "x_prompt": nrm(ks[0], (BATCH, SEQ, D_MODEL)),
        "x_sample": nrm(ks[1], (DEC_BATCH, DEC_SEQ, D_MODEL)),
        "cache_diff_k": nrm(ks[2], (DEPTH, DEC_BATCH, PAST_LEN, DIFF_HEADS, 2, DIFF_HEAD_DIM)),
        "cache_diff_v": nrm(ks[3], (DEPTH, DEC_BATCH, PAST_LEN, DIFF_HEADS, 2 * DIFF_HEAD_DIM)),
        "cache_mla_ckv": nrm(ks[4], (DEPTH, DEC_BATCH, PAST_LEN, MLA_KV_LORA)),
        "cache_mla_krope": nrm(ks[5], (DEPTH, DEC_BATCH, PAST_LEN, MLA_ROPE)),
        "state_conv": nrm(ks[6], (DEPTH, DEC_BATCH, CONV_W - 1, D_FF)),
        "g_attn": gain(ks[7], (DEPTH, D_MODEL)),
        "w_in": nrm(ks[8], (DEPTH, D_MODEL, IN_COLS), D_MODEL ** -0.5),
        "lambda_q1": nrm(ks[9], (DEPTH, DIFF_HEAD_DIM), 0.1),
        "lambda_k1": nrm(ks[10], (DEPTH, DIFF_HEAD_DIM), 0.1),
        "lambda_q2": nrm(ks[11], (DEPTH, DIFF_HEAD_DIM), 0.1),
        "lambda_k2": nrm(ks[12], (DEPTH, DIFF_HEAD_DIM), 0.1),
        "g_diff_sub": gain(ks[13], (DEPTH, 2 * DIFF_HEAD_DIM)),
        "g_q_lora": gain(ks[14], (DEPTH, MLA_Q_LORA)),
        "w_q_b": nrm(ks[15], (DEPTH, MLA_Q_LORA, MLA_HEADS * (MLA_NOPE + MLA_ROPE)), MLA_Q_LORA ** -0.5),
        "g_kv_lora": gain(ks[16], (DEPTH, MLA_KV_LORA)),
        "w_kv_b": nrm(ks[17], (DEPTH, MLA_KV_LORA, MLA_HEADS * (MLA_NOPE + MLA_V)), MLA_KV_LORA ** -0.5),
        "w_out": nrm(ks[18], (DEPTH, MIX_WIDTH, D_MODEL), MIX_WIDTH ** -0.5),
        "g_ffn": gain(ks[19], (DEPTH, D_MODEL)),
        "w_up": nrm(ks[20], (DEPTH, D_MODEL, 2 * D_FF), D_MODEL ** -0.5),
        "w_conv": nrm(ks[21], (DEPTH, CONV_W, D_FF), CONV_W ** -0.5),
        "b_conv": nrm(ks[22], (DEPTH, D_FF), 0.01),
        "w_down": nrm(ks[23], (DEPTH, D_FF, D_MODEL), D_FF ** -0.5),
        "g_final": gain(ks[24], (D_MODEL,)),
    }


def reference(x_prompt, x_sample, cache_diff_k, cache_diff_v, cache_mla_ckv, cache_mla_krope,
              state_conv, g_attn, w_in, lambda_q1, lambda_k1, lambda_q2, lambda_k2, g_diff_sub,
              g_q_lora, w_q_b, g_kv_lora, w_kv_b, w_out, g_ffn, w_up, w_conv, b_conv, w_down,
              g_final):
    S = x_prompt.shape[1]
    T = x_sample.shape[1]
    P = cache_diff_k.shape[2]
    pos_p = jnp.arange(S, dtype=jnp.int32)
    pos_s = P + jnp.arange(T, dtype=jnp.int32)
    hp, hs = x_prompt, x_sample
    st_p, st_s = [], []
    for l in range(DEPTH):
        lam_init = 0.8 - 0.6 * math.exp(-0.3 * l)
        wl = (g_attn[l], w_in[l], lambda_q1[l], lambda_k1[l], lambda_q2[l], lambda_k2[l],
              g_diff_sub[l], g_q_lora[l], w_q_b[l], g_kv_lora[l], w_kv_b[l], w_out[l],
              g_ffn[l], w_up[l], w_conv[l], b_conv[l], w_down[l])
        hp, sp = hybrid_layer(hp, pos_p, None, lam_init, *wl)
        past = (cache_diff_k[l], cache_diff_v[l], cache_mla_ckv[l], cache_mla_krope[l], state_conv[l])
        hs, ss = hybrid_layer(hs, pos_s, past, lam_init, *wl)
        st_p.append(sp)
        st_s.append(ss)
    y_prompt = rmsnorm(hp, g_final)
    y_sample = rmsnorm(hs, g_final)
    new_diff_k_p = jnp.stack([s[0] for s in st_p], 0)
    new_diff_v_p = jnp.stack([s[1] for s in st_p], 0)
    new_mla_ckv_p = jnp.stack([s[2] for s in st_p], 0)
    new_mla_krope_p = jnp.stack([s[3] for s in st_p], 0)
    new_conv_p = jnp.stack([s[4] for s in st_p], 0)
    new_diff_k_s = jnp.stack([s[0] for s in st_s], 0)
    new_diff_v_s = jnp.stack([s[1] for s in st_s], 0)
    new_mla_ckv_s = jnp.stack([s[2] for s in st_s], 0)
    new_mla_krope_s = jnp.stack([s[3] for s in st_s], 0)
    new_conv_s = jnp.stack([s[4] for s in st_s], 0)
    return (y_prompt, y_sample, new_diff_k_p, new_diff_v_p, new_mla_ckv_p, new_mla_krope_p,
            new_conv_p, new_diff_k_s, new_diff_v_s, new_mla_ckv_s, new_mla_krope_s, new_conv_s)
```

```cpp
#include <hip/hip_runtime.h>
#include <hip/hip_cooperative_groups.h>
#include <cstdio>
#include <cstdint>
namespace cg = cooperative_groups;
namespace pg8 {
#define PG8_LAS __attribute__((address_space(3)))
typedef unsigned short bf16_t;
typedef short bf16x8 __attribute__((ext_vector_type(8)));
typedef float f32x4 __attribute__((ext_vector_type(4)));
typedef unsigned u32x4 __attribute__((ext_vector_type(4)));
constexpr int BM = 256, BK = 64, HALF = 128, HTB = HALF * BK * 2  , STAGE_BYTES = 8 * HTB, NXCD = 8, WGM = 8;

__host__ __device__ __forceinline__ int lds_byte(int r, int c) { const int st = (r >> 4) * 2 + (c >> 5), rr = r & 15, cc = c & 31, ob = rr * 64 + cc * 2; return st * 1024 + (ob ^ (((ob >> 9) & 1) << 5)); }
__host__ __device__ __forceinline__ void stage_rc(int b, int& R, int& C) { const int st = b / 1024, sb = b % 1024, swz = sb ^ (((sb >> 9) & 1) << 5); R = (st >> 1) * 16 + swz / 64; C = (st & 1) * 32 + (swz % 64) / 2; }
__host__ __device__ __forceinline__ int perm32(int rho) { const int n = rho >> 4, i = rho & 15; return 8 * (i >> 2) + 4 * n + (i & 3); }

struct Unit { int pm, pn; };
struct Gemm { const bf16_t* A; const bf16_t* Bt; int M, N, K; };
struct StaticOrder {
    int nM, nN, nwg, G, c;
    __host__ __device__ void init(int M, int N, int G_, int c_) { nM = M / BM; nN = N / BM; nwg = nM * nN; G = G_; c = c_; }
    __host__ __device__ bool next(int i, Unit& u) const {
        const long L = (long)i * G + c; if (L >= nwg) return false;
        int wgid = (int)L; { const int q = nwg / NXCD, r = nwg % NXCD, xcd = wgid % NXCD, off = wgid / NXCD; wgid = (xcd < r ? xcd * (q + 1) : r * (q + 1) + (xcd - r) * q) + off; }
        const int nig = WGM * nN, gid = wgid / nig, fm = gid * WGM, gsz = (nM - fm) < WGM ? (nM - fm) : WGM;
        u.pm = fm + ((wgid % nig) % gsz); u.pn = (wgid % nig) / gsz; return true;
    }
    __device__ __forceinline__ void a_ready(const Unit&) const {}
    __device__ __forceinline__ void done(const Unit&) const {}
};
__device__ __forceinline__ unsigned cvt_pk_bf16(float lo, float hi) { unsigned r; asm volatile("v_cvt_pk_bf16_f32 %0, %1, %2" : "=v"(r) : "v"(lo), "v"(hi)); return r; }
typedef float f32x2 __attribute__((ext_vector_type(2)));
template <class Epi, class Sched, bool ALIGN_EPI = false, bool SP2 = false>
__device__ __forceinline__ void gemm_phase(PG8_LAS unsigned char* lds, const Gemm g, const Sched& S, const Epi& E, const int tid_in) {
    const int tid = tid_in;
    const int wid = __builtin_amdgcn_readfirstlane(tid >> 6), lane = tid & 63, wr = wid >> 2, wc = wid & 3, fr = lane & 15, fq = lane >> 4;
    const int K = g.K, nt = K / BK;
    unsigned voffA[2], voffB[2];
#pragma unroll
    for (int i = 0; i < 2; ++i) { int R, C; stage_rc(tid * 16 + i * 8192, R, C); const int Rb = Epi::PERM ? ((R & ~31) + perm32(R & 31)) : R;
        voffA[i] = (unsigned)(R * K + C) * 2u; voffB[i] = (unsigned)(Rb * K + C) * 2u; }
    const size_t kstep = (size_t)(BK * 2);
    const size_t hstep = (size_t)HALF * K * 2;
    const size_t tstep = 2 * hstep;
    const unsigned ldsw = (unsigned)wid * 1024u;
    const int aoff = lds_byte(wr * 64 + fr, fq * 8), boff = lds_byte(wc * 32 + fr, fq * 8);
#define PG8_SA(b, h) (((b) * 2 + (h)) * HTB)
#define PG8_SB(b, h) ((4 + (b) * 2 + (h)) * HTB)
#define PG8_STAGE(bufoff, gbase, voff) do { _Pragma("unroll") for (int _i = 0; _i < 2; ++_i) \
        __builtin_amdgcn_global_load_lds((const unsigned*)((const char*)(gbase) + (voff)[_i]), (PG8_LAS unsigned*)(lds + (bufoff) + ldsw + _i * 8192), 16, 0, 0); } while (0)
#define PG8_LDA(dst, b, h) do { _Pragma("unroll") for (int m = 0; m < 4; ++m) _Pragma("unroll") for (int k = 0; k < 2; ++k) dst[m][k] = *(const PG8_LAS bf16x8*)(lds + PG8_SA(b, h) + aoff + m * 2048 + k * 1024); } while (0)
#define PG8_LDB(dst, b, h) do { _Pragma("unroll") for (int n = 0; n < 2; ++n) _Pragma("unroll") for (int k = 0; k < 2; ++k) dst[n][k] = *(const PG8_LAS bf16x8*)(lds + PG8_SB(b, h) + boff + n * 2048 + k * 1024); } while (0)
#define PG8_MMA(ai, bj, At, Bt) do { __builtin_amdgcn_s_setprio(1); _Pragma("unroll") for (int m = 0; m < 4; ++m) _Pragma("unroll") for (int n = 0; n < 2; ++n) _Pragma("unroll") for (int k = 0; k < 2; ++k) \
        acc[ai][bj][m][n] = __builtin_amdgcn_mfma_f32_16x16x32_bf16(Bt[n][k], At[m][k], acc[ai][bj][m][n], 0, 0, 0); __builtin_amdgcn_s_setprio(0); } while (0)
#define PG8_WAIT_V(n) asm volatile("s_waitcnt vmcnt(" #n ")" ::: "memory")
#define PG8_WAIT_L(n) asm volatile("s_waitcnt lgkmcnt(" #n ")" ::: "memory")
#define PG8_BAR __builtin_amdgcn_s_barrier()
#define PG8_SCHED __builtin_amdgcn_sched_barrier(0)
    Unit cur, nxt; int ui = 0;
    if (!S.next(0, cur)) return;
    f32x4 acc[2][2][4][2];
#pragma unroll
    for (int a = 0; a < 2; ++a)
#pragma unroll
        for (int b = 0; b < 2; ++b)
#pragma unroll
            for (int m = 0; m < 4; ++m)
#pragma unroll
                for (int n = 0; n < 2; ++n) acc[a][b][m][n] = (f32x4){0.f, 0.f, 0.f, 0.f};
    bf16x8 At[4][2], B0[2][2], B1[2][2];
    const char* cA = (const char*)g.A + (size_t)cur.pm * tstep; const char* cB = (const char*)g.Bt + (size_t)cur.pn * tstep;
    S.a_ready(cur);
    if constexpr (SP2) {
        PG8_STAGE(PG8_SB(0, 0), cB, voffB); PG8_STAGE(PG8_SB(0, 1), cB + hstep, voffB); PG8_STAGE(PG8_SA(0, 0), cA, voffA); PG8_STAGE(PG8_SA(0, 1), cA + hstep, voffA);
        if (wr == 1) PG8_BAR;
        PG8_WAIT_V(2); PG8_BAR;
        PG8_STAGE(PG8_SB(1, 0), cB + kstep, voffB); PG8_STAGE(PG8_SA(1, 0), cA + kstep, voffA); PG8_STAGE(PG8_SB(1, 1), cB + hstep + kstep, voffB);
        PG8_WAIT_V(6); PG8_BAR;
    } else {
        PG8_STAGE(PG8_SB(0, 0), cB, voffB); PG8_STAGE(PG8_SA(0, 0), cA, voffA); PG8_STAGE(PG8_SB(0, 1), cB + hstep, voffB); PG8_STAGE(PG8_SA(0, 1), cA + hstep, voffA);
        if (wr == 1) PG8_BAR;
        PG8_WAIT_V(4); PG8_BAR;
        PG8_STAGE(PG8_SB(1, 0), cB + kstep, voffB); PG8_STAGE(PG8_SA(1, 0), cA + kstep, voffA); PG8_STAGE(PG8_SB(1, 1), cB + hstep + kstep, voffB);
        PG8_WAIT_V(6); PG8_BAR;
    }
    for (;;) {
        const bool has_next = S.next(ui + 1, nxt);
        const char* nA = has_next ? (const char*)g.A + (size_t)nxt.pm * tstep : cA; const char* nB = has_next ? (const char*)g.Bt + (size_t)nxt.pn * tstep : cB;
        for (int t = 0; t < nt; t += 2) {
            const bool last = (t == nt - 2);
            const char* a1 = cA + (size_t)(t + 1) * kstep;
            const char* a2 = last ? nA : cA + (size_t)(t + 2) * kstep; const char* b2 = last ? nB : cB + (size_t)(t + 2) * kstep;
            const char* a3 = a2 + kstep; const char* b3 = b2 + kstep;
            if (last && has_next) S.a_ready(nxt);
            if constexpr (SP2) {
            PG8_LDB(B0, 0, 0); PG8_LDB(B1, 0, 1); PG8_SCHED; PG8_LDA(At, 0, 0); PG8_STAGE(PG8_SA(1, 1), a1 + hstep, voffA);
            PG8_WAIT_V(8); PG8_WAIT_L(0); PG8_BAR; PG8_MMA(0, 0, At, B0); PG8_MMA(0, 1, At, B1); PG8_BAR; PG8_SCHED;
            PG8_LDA(At, 0, 1); PG8_STAGE(PG8_SB(0, 0), b2, voffB); PG8_STAGE(PG8_SB(0, 1), b2 + hstep, voffB); PG8_STAGE(PG8_SA(0, 0), a2, voffA);
            PG8_WAIT_V(8); PG8_WAIT_L(0); PG8_BAR; PG8_MMA(1, 0, At, B0); PG8_MMA(1, 1, At, B1); PG8_BAR; PG8_SCHED;
            PG8_LDB(B0, 1, 0); PG8_LDB(B1, 1, 1); PG8_SCHED; PG8_LDA(At, 1, 0); PG8_STAGE(PG8_SA(0, 1), a2 + hstep, voffA);
            PG8_WAIT_V(8); PG8_WAIT_L(0); PG8_BAR; PG8_MMA(0, 0, At, B0); PG8_MMA(0, 1, At, B1); PG8_BAR; PG8_SCHED;
            PG8_LDA(At, 1, 1); PG8_STAGE(PG8_SB(1, 0), b3, voffB); PG8_STAGE(PG8_SB(1, 1), b3 + hstep, voffB); PG8_STAGE(PG8_SA(1, 0), a3, voffA);
            PG8_WAIT_V(8); PG8_WAIT_L(0); PG8_BAR; PG8_MMA(1, 0, At, B0); PG8_MMA(1, 1, At, B1); PG8_BAR; PG8_SCHED;
            } else {
            PG8_LDB(B0, 0, 0); PG8_SCHED; PG8_LDA(At, 0, 0); PG8_STAGE(PG8_SA(1, 1), a1 + hstep, voffA);
            PG8_WAIT_L(8); PG8_BAR; PG8_WAIT_L(0); PG8_MMA(0, 0, At, B0); PG8_BAR; PG8_SCHED;
            PG8_LDB(B1, 0, 1); PG8_STAGE(PG8_SB(0, 0), b2, voffB);
            PG8_BAR; PG8_WAIT_L(0); PG8_MMA(0, 1, At, B1); PG8_BAR;
            PG8_LDA(At, 0, 1); PG8_STAGE(PG8_SA(0, 0), a2, voffA);
            PG8_BAR; PG8_WAIT_L(0); PG8_MMA(1, 0, At, B0); PG8_BAR; PG8_SCHED;
            PG8_STAGE(PG8_SB(0, 1), b2 + hstep, voffB);
            PG8_WAIT_V(6); PG8_BAR; PG8_MMA(1, 1, At, B1); PG8_BAR;
            PG8_LDB(B0, 1, 0); PG8_SCHED; PG8_LDA(At, 1, 0); PG8_STAGE(PG8_SA(0, 1), a2 + hstep, voffA);
            PG8_WAIT_L(8); PG8_BAR; PG8_WAIT_L(0); PG8_MMA(0, 0, At, B0); PG8_BAR; PG8_SCHED;
            PG8_LDB(B1, 1, 1); PG8_STAGE(PG8_SB(1, 0), b3, voffB);
            PG8_BAR; PG8_WAIT_L(0); PG8_MMA(0, 1, At, B1); PG8_BAR;
            PG8_LDA(At, 1, 1); PG8_STAGE(PG8_SA(1, 0), a3, voffA);
            PG8_BAR; PG8_WAIT_L(0); PG8_MMA(1, 0, At, B0); PG8_BAR; PG8_SCHED;
            PG8_STAGE(PG8_SB(1, 1), b3 + hstep, voffB);
            PG8_WAIT_V(6); PG8_BAR; PG8_MMA(1, 1, At, B1); PG8_BAR;
            }
        }
        if constexpr (ALIGN_EPI) { if (wr == 0) PG8_BAR; }
        if constexpr (!Epi::AFTER_DRAIN) { E(acc, cur, wr, wc, fr, fq); S.done(cur); }
        if (!has_next) break;
#pragma unroll
        for (int a = 0; a < 2; ++a)
#pragma unroll
            for (int b = 0; b < 2; ++b)
#pragma unroll
                for (int m = 0; m < 4; ++m)
#pragma unroll
                    for (int n = 0; n < 2; ++n) acc[a][b][m][n] = (f32x4){0.f, 0.f, 0.f, 0.f};
        cur = nxt; cA = nA; cB = nB; ++ui;
        if constexpr (ALIGN_EPI) { if (wr == 1) PG8_BAR; }
    }
    PG8_WAIT_V(0);
    if constexpr (!ALIGN_EPI) { if (wr == 0) PG8_BAR; }
    PG8_BAR;
    if constexpr (Epi::AFTER_DRAIN) { E.fused(acc, cur, wr, wc, fr, fq, lds, wid, lane); S.done(cur); }
#undef PG8_SA
#undef PG8_SB
#undef PG8_STAGE
#undef PG8_LDA
#undef PG8_LDB
#undef PG8_MMA
#undef PG8_WAIT_V
#undef PG8_WAIT_L
#undef PG8_BAR
#undef PG8_SCHED
}
}

namespace mk {
#define LAS __attribute__((address_space(3)))
#define GAS __attribute__((address_space(1)))
using pg8::bf16_t; using pg8::f32x4; using pg8::u32x4; using pg8::Unit;
typedef short bf16x8 __attribute__((ext_vector_type(8)));
typedef float f32x16 __attribute__((ext_vector_type(16)));
typedef unsigned u32x2 __attribute__((ext_vector_type(2)));
typedef float f32x2_t __attribute__((ext_vector_type(2)));
typedef __bf16 bf16x2_t __attribute__((ext_vector_type(2)));

constexpr int DM = 1024, SEQ = 4096, MP = 65536, PAST = 1024, MS = 512, MT = MP + MS, SLEN = 1088, DBATCH = 8, KR = MP + DBATCH * SLEN, DFF = 2816;
constexpr float LOG2E = 1.4426950408889634f;
constexpr float QS_D = 0.125f * LOG2E;
constexpr float QS_M = 0.07216878364870322f * LOG2E;
constexpr float EPS = 1e-6f;
constexpr float LAM_INIT = 0.2f;

constexpr size_t O_Y = 0, O_DKP = 67633152, O_DVP = 101187584, O_CKVP = 134742016, O_KRP = 143130624, O_CONVP = 147324928,
                 O_DKS = 147415040, O_DVS = 147677184, O_CKVS = 147939328, O_KRS = 148004864, O_CONVS = 148037632, O_TOTAL = 148082688;

constexpr size_t al(size_t x) { return (x + 255) & ~(size_t)255; }
constexpr size_t WS_BAR = 0, WS_BAR_BYTES = 16384;
constexpr size_t WS_ROPE = 16384;
constexpr size_t WS_WIN = al(WS_ROPE + 4096 * 64 * 4);
constexpr size_t WS_WQB = al(WS_WIN + 2048 * 1024 * 2);
constexpr size_t WS_WKVB = al(WS_WQB + 768 * 256 * 2);
constexpr size_t WS_WOUT = al(WS_WKVB + 1024 * 128 * 2);
constexpr size_t WS_WUP = al(WS_WOUT + 1024 * 1024 * 2);
constexpr size_t WS_WDN = al(WS_WUP + 5632 * 1024 * 2);
constexpr size_t WS_RSQ = al(WS_WDN + 1024 * 2816 * 2);
constexpr size_t WS_RSQ2 = al(WS_RSQ + (size_t)66048 * 4);
constexpr size_t WS_RSQQ = al(WS_RSQ2 + (size_t)66048 * 4);
constexpr size_t WS_ACT = al(WS_RSQQ + (size_t)66048 * 4);
constexpr size_t WS_BIG = al(WS_ACT + (size_t)MT * 1024 * 2);
constexpr size_t WS_QD = WS_BIG;
constexpr size_t WS_KD = al(WS_QD + (size_t)MT * 512 * 2);
constexpr size_t WS_VTD = al(WS_KD + (size_t)KR * 512 * 2);
constexpr size_t WS_CQRAW = al(WS_VTD + (size_t)KR * 512 * 2);
constexpr size_t WS_CKVRAW = al(WS_CQRAW + (size_t)MT * 256 * 4);
constexpr size_t WS_CQ = al(WS_CKVRAW + (size_t)MT * 128 * 4);
constexpr size_t WS_CKV = al(WS_CQ + (size_t)MT * 256 * 2);
constexpr size_t WS_QM = al(WS_CKV + (size_t)KR * 128 * 2);
constexpr size_t WS_KM = al(WS_QM + (size_t)MT * 768 * 2);
constexpr size_t WS_VTM = al(WS_KM + (size_t)KR * 768 * 2);
constexpr size_t WS_ATT_END = al(WS_VTM + (size_t)KR * 512 * 2);
constexpr size_t WS_U = WS_BIG;
constexpr size_t WS_GS0 = al(WS_U + (size_t)MT * DFF * 2);
constexpr size_t WS_GS1 = al(WS_GS0 + (size_t)(MT / 64) * 2 * DFF * 4);
constexpr size_t WS_FFN_END = al(WS_GS1 + (size_t)(MT / 64) * 2 * DFF * 4);
constexpr size_t WS_H2 = WS_FFN_END;
constexpr size_t WS_H2_END = al(WS_H2 + (size_t)MT * 1024 * 2);
constexpr size_t WS_O0 = WS_ATT_END;
constexpr size_t WS_O0_END = al(WS_O0 + (size_t)256 * 64 * 512 * 4);
constexpr size_t WS_NEED = WS_O0_END > WS_H2_END ? WS_O0_END : WS_H2_END;

constexpr int LDS_BYTES = 147456;

struct Params { const float* in[25]; float* out; unsigned char* ws; };
constexpr int PARAM_OFF = 131072 + 1024;
struct PTab {
    LAS unsigned char* l;
    __device__ __forceinline__ unsigned long long ld(int k) const {
        const unsigned long long v = *(volatile LAS unsigned long long*)(l + PARAM_OFF + 8 * k);
        const unsigned lo = __builtin_amdgcn_readfirstlane((unsigned)v), hi = __builtin_amdgcn_readfirstlane((unsigned)(v >> 32));
        return ((unsigned long long)hi << 32) | lo;
    }
    __device__ __forceinline__ const float* in(int k) const { return (const float*)(const GAS float*)ld(k); }
    __device__ __forceinline__ float* out() const { return (float*)(GAS float*)ld(25); }
    __device__ __forceinline__ unsigned char* ws() const { return (unsigned char*)(GAS unsigned char*)ld(26); }
};

__device__ __forceinline__ unsigned pk2(float lo, float hi) { f32x2_t v = {lo, hi}; bf16x2_t b = __builtin_convertvector(v, bf16x2_t); return __builtin_bit_cast(unsigned, b); }
__device__ __forceinline__ bf16_t f2bf(float f) { return (bf16_t)(pk2(f, 0.f) & 0xffffu); }
__device__ __forceinline__ float bflo(unsigned w) { return __uint_as_float(w << 16); }
__device__ __forceinline__ float bfhi(unsigned w) { return __uint_as_float(w & 0xffff0000u); }
__device__ __forceinline__ float wave_sum(float v) {
#pragma unroll
    for (int o = 1; o < 64; o <<= 1) v += __shfl_xor(v, o);
    return v;
}
__device__ __forceinline__ int phase_tid(int wid_s) {
    int l; asm volatile("v_mbcnt_lo_u32_b32 %0, -1, 0\n\tv_mbcnt_hi_u32_b32 %0, -1, %0" : "=v"(l)); return wid_s * 64 + l;
}
__device__ __forceinline__ int permk(int k) { return (k & ~12) | ((k & 4) << 1) | ((k & 8) >> 1); }
__device__ __forceinline__ void tok_row(int r, int& pos, int& kr, int& kl, int& len) {
    if (r < MP) { pos = r & 4095; kr = r; kl = pos; len = SEQ; }
    else { const int j = r - MP, b = j >> 6, t = j & 63; pos = PAST + t; kl = PAST + t; kr = MP + b * SLEN + kl; len = SLEN; }
}
__device__ __forceinline__ void key_row(int kr, int& kl, int& len) {
    if (kr < MP) { kl = kr & 4095; len = SEQ; }
    else { const int j = kr - MP, b = j / SLEN; kl = j - b * SLEN; len = SLEN; }
}
__device__ __forceinline__ float* out_row(float* out, int r, size_t op, size_t os, int w) {
    return r < MP ? out + op + (size_t)r * w : out + os + (size_t)(r - MP) * w;
}
__device__ __forceinline__ u32x4 pack8(f32x4 a, f32x4 b) { u32x4 w; w.x = pk2(a[0], a[1]); w.y = pk2(a[2], a[3]); w.z = pk2(b[0], b[1]); w.w = pk2(b[2], b[3]); return w; }

struct EpiIn {
    static constexpr bool PERM = true, AFTER_DRAIN = false;
    float* out; bf16_t *qd, *kd, *vtd, *km; float *cqraw, *ckvraw; const float* rope; int novt; bf16_t* cq; const float* gq; float* rsqq;
    __device__ __forceinline__ void operator()(const f32x4 (&acc)[2][2][4][2], const Unit& u, int wr, int wc, int fr, int fq) const {
        const int pn = u.pn;
        const bool do_rope = (pn < 4) || (pn == 7 && wc == 2);
#pragma unroll
        for (int ai = 0; ai < 2; ++ai)
#pragma unroll
            for (int m = 0; m < 4; ++m) {
                const int r = u.pm * 256 + ai * 128 + wr * 64 + m * 16 + fr;
                int pos, kr, kl, len; tok_row(r, pos, kr, kl, len);
                if (do_rope) {
                    const float* cs = rope + pos * 64 + 8 * fq;
                    const f32x4 c0 = *(const f32x4*)cs, c1 = *(const f32x4*)(cs + 4), s0 = *(const f32x4*)(cs + 32), s1 = *(const f32x4*)(cs + 36);
                    const f32x4 x10 = acc[ai][0][m][0], x11 = acc[ai][0][m][1], x20 = acc[ai][1][m][0], x21 = acc[ai][1][m][1];
                    f32x4 a0 = x10 * c0 - x20 * s0, a1 = x11 * c1 - x21 * s1, b0 = x20 * c0 + x10 * s0, b1 = x21 * c1 + x11 * s1;
                    if (pn < 2) {
                        const int g = 4 * pn + wc;
                        bf16_t* d = qd + (size_t)r * 512 + 64 * g + 8 * fq;
                        *(u32x4*)d = pack8(a0 * QS_D, a1 * QS_D); *(u32x4*)(d + 32) = pack8(b0 * QS_D, b1 * QS_D);
                    } else if (pn < 4) {
                        const int g = 4 * (pn - 2) + wc;
                        float* o = out_row(out, r, O_DKP, O_DKS, 512) + 64 * g + 8 * fq;
                        *(f32x4*)o = a0; *(f32x4*)(o + 4) = a1; *(f32x4*)(o + 32) = b0; *(f32x4*)(o + 36) = b1;
                        bf16_t* d = kd + (size_t)kr * 512 + 64 * g + 8 * fq;
                        *(u32x4*)d = pack8(a0, a1); *(u32x4*)(d + 32) = pack8(b0, b1);
                    } else {
                        float* o = out_row(out, r, O_KRP, O_KRS, 64) + 8 * fq;
                        *(f32x4*)o = a0; *(f32x4*)(o + 4) = a1; *(f32x4*)(o + 32) = b0; *(f32x4*)(o + 36) = b1;
                        const u32x4 wa = pack8(a0, a1), wb = pack8(b0, b1);
#pragma unroll
                        for (int hh = 0; hh < 4; ++hh) { bf16_t* d = km + (size_t)kr * 768 + hh * 192 + 128 + 8 * fq; *(u32x4*)d = wa; *(u32x4*)(d + 32) = wb; }
                    }
                } else if (pn < 6) {
                    const int g = 4 * (pn - 4) + wc;
                    float* o = out_row(out, r, O_DVP, O_DVS, 512) + 64 * g + 8 * fq;
                    const bool odd = (fr & 1) != 0;
                    bf16_t* vb = vtd + (size_t)(kr - kl) * 512 + permk(kl & ~1);
#pragma unroll
                    for (int bj = 0; bj < 2; ++bj) {
                        *(f32x4*)(o + 32 * bj) = acc[ai][bj][m][0]; *(f32x4*)(o + 32 * bj + 4) = acc[ai][bj][m][1];
                        const f32x4 mine = odd ? acc[ai][bj][m][1] : acc[ai][bj][m][0], send = odd ? acc[ai][bj][m][0] : acc[ai][bj][m][1];
#pragma unroll
                        for (int e = 0; e < 4; ++e) {
                            const float recv = __shfl_xor(send[e], 1);
                            const int col = 64 * g + 32 * bj + 8 * fq + (odd ? 4 : 0) + e;
                            if (!novt) *(unsigned*)(vb + (size_t)col * len) = odd ? pk2(recv, mine[e]) : pk2(mine[e], recv);
                        }
                    }
                } else if (pn == 6) {
                    const int c = 64 * wc + 8 * fq; float ss = 0.f;
#pragma unroll
                    for (int bj = 0; bj < 2; ++bj) {
                        const f32x4 y0 = acc[ai][bj][m][0], y1 = acc[ai][bj][m][1];
                        const f32x4 g0 = *(const f32x4*)(gq + c + 32 * bj), g1 = *(const f32x4*)(gq + c + 32 * bj + 4);
                        *(u32x4*)(cq + (size_t)r * 256 + c + 32 * bj) = pack8(y0 * g0, y1 * g1);
                        ss += (y0[0] * y0[0] + y0[1] * y0[1]) + (y0[2] * y0[2] + y0[3] * y0[3]) + (y1[0] * y1[0] + y1[1] * y1[1]) + (y1[2] * y1[2] + y1[3] * y1[3]);
                    }
                    ss += __shfl_xor(ss, 16); ss += __shfl_xor(ss, 32);
                    if (fq == 0) atomicAdd(rsqq + r, ss);
                } else if (wc < 2) {
                    float* o = ckvraw + (size_t)r * 128 + 64 * wc + 8 * fq;
#pragma unroll
                    for (int bj = 0; bj < 2; ++bj) { *(f32x4*)(o + 32 * bj) = acc[ai][bj][m][0]; *(f32x4*)(o + 32 * bj + 4) = acc[ai][bj][m][1]; }
                }
                asm volatile("" ::: "memory");
            }
    }
};

struct EpiQm {
    static constexpr bool PERM = true, AFTER_DRAIN = false;
    bf16_t* qm; const float* rope; const float* rsqq;
    __device__ __forceinline__ void operator()(const f32x4 (&acc)[2][2][4][2], const Unit& u, int wr, int wc, int fr_in, int fq_in) const {
        int fr = fr_in, fq = fq_in; asm volatile("" : "+v"(fr), "+v"(fq));
        const int pn = u.pn;
#pragma unroll
        for (int ai = 0; ai < 2; ++ai)
#pragma unroll
            for (int m = 0; m < 4; ++m) {
                const int r = u.pm * 256 + ai * 128 + wr * 64 + m * 16 + fr;
                const float qs = QS_M * rsqrtf(rsqq[r] * (1.f / 256.f) + EPS);
                if (pn < 2) {
#pragma unroll
                    for (int bj = 0; bj < 2; ++bj) {
                        bf16_t* d = qm + (size_t)r * 768 + (2 * pn + bj) * 192 + 32 * wc + 8 * fq;
                        *(u32x4*)d = pack8(acc[ai][bj][m][0] * qs, acc[ai][bj][m][1] * qs);
                    }
                } else {
                    int pos, kr, kl, len; tok_row(r, pos, kr, kl, len);
                    const float* cs = rope + pos * 64 + 8 * fq;
                    const f32x4 c0 = *(const f32x4*)cs, c1 = *(const f32x4*)(cs + 4), s0 = *(const f32x4*)(cs + 32), s1 = *(const f32x4*)(cs + 36);
                    const f32x4 x10 = acc[ai][0][m][0], x11 = acc[ai][0][m][1], x20 = acc[ai][1][m][0], x21 = acc[ai][1][m][1];
                    f32x4 a0 = x10 * c0 - x20 * s0, a1 = x11 * c1 - x21 * s1, b0 = x20 * c0 + x10 * s0, b1 = x21 * c1 + x11 * s1;
                    bf16_t* d = qm + (size_t)r * 768 + wc * 192 + 128 + 8 * fq;
                    *(u32x4*)d = pack8(a0 * qs, a1 * qs); *(u32x4*)(d + 32) = pack8(b0 * qs, b1 * qs);
                }
                asm volatile("" ::: "memory");
            }
    }
};

struct EpiKv {
    static constexpr bool PERM = true, AFTER_DRAIN = false;
    bf16_t *km, *vtm;
    __device__ __forceinline__ void operator()(const f32x4 (&acc)[2][2][4][2], const Unit& u, int wr, int wc, int fr, int fq) const {
        const int hd = u.pn;
#pragma unroll
        for (int ai = 0; ai < 2; ++ai)
#pragma unroll
            for (int m = 0; m < 4; ++m) {
                const int kr = u.pm * 256 + ai * 128 + wr * 64 + m * 16 + fr;
                int kl, len; key_row(kr, kl, len);
                bf16_t* d = km + (size_t)kr * 768 + hd * 192 + 32 * wc + 8 * fq;
                *(u32x4*)d = pack8(acc[ai][0][m][0], acc[ai][0][m][1]);
                const bool odd = (fr & 1) != 0;
                bf16_t* vb = vtm + (size_t)(kr - kl) * 512 + (size_t)(hd * 128) * len + permk(kl & ~1);
                const f32x4 mine = odd ? acc[ai][1][m][1] : acc[ai][1][m][0], send = odd ? acc[ai][1][m][0] : acc[ai][1][m][1];
#pragma unroll
                for (int e = 0; e < 4; ++e) {
                    const float recv = __shfl_xor(send[e], 1);
                    const int dv = 32 * wc + 8 * fq + (odd ? 4 : 0) + e;
                    *(unsigned*)(vb + (size_t)dv * len) = odd ? pk2(recv, mine[e]) : pk2(mine[e], recv);
                }
            }
    }
};

struct EpiOut {
    static constexpr bool PERM = true, AFTER_DRAIN = false;
    const float* xp; const float* xs; bf16_t* h2; const float* gain; float* rowsq;
    __device__ __forceinline__ void operator()(const f32x4 (&acc)[2][2][4][2], const Unit& u, int wr, int wc, int fr, int fq) const {
#pragma unroll
        for (int ai = 0; ai < 2; ++ai)
#pragma unroll
            for (int m = 0; m < 4; ++m) {
                const int r = u.pm * 256 + ai * 128 + wr * 64 + m * 16 + fr;
                const float* x = r < MP ? xp + (size_t)r * 1024 : xs + (size_t)(r - MP) * 1024;
                float ss = 0.f;
#pragma unroll
                for (int bj = 0; bj < 2; ++bj) {
                    const int c = u.pn * 256 + 128 * bj + 32 * wc + 8 * fq;
                    const f32x4 r0 = *(const f32x4*)(x + c), r1 = *(const f32x4*)(x + c + 4);
                    const f32x4 y0 = r0 + acc[ai][bj][m][0], y1 = r1 + acc[ai][bj][m][1];
                    const f32x4 g0 = *(const f32x4*)(gain + c), g1 = *(const f32x4*)(gain + c + 4);
                    *(u32x4*)(h2 + (size_t)r * 1024 + c) = pack8(y0 * g0, y1 * g1);
                    ss += (y0[0] * y0[0] + y0[1] * y0[1]) + (y0[2] * y0[2] + y0[3] * y0[3]) + (y1[0] * y1[0] + y1[1] * y1[1]) + (y1[2] * y1[2] + y1[3] * y1[3]);
                }
                ss += __shfl_xor(ss, 16); ss += __shfl_xor(ss, 32);
                if (fq == 0) atomicAdd(rowsq + r, ss);
                asm volatile("" ::: "memory");
            }
    }
};

struct RevOrder : pg8::StaticOrder {
    __device__ __forceinline__ bool next(int i, Unit& u) const { const bool ok = pg8::StaticOrder::next(i, u); if (ok) u.pm = nM - 1 - u.pm; return ok; }
};

struct EpiDown {
    static constexpr bool PERM = true, AFTER_DRAIN = false;
    const bf16_t* h2; const float* gain; bf16_t* yb; float* rowsq; int row0;
    __device__ __forceinline__ void operator()(const f32x4 (&acc)[2][2][4][2], const Unit& u, int wr, int wc, int fr, int fq) const {
        f32x4 gi[2][2];
#pragma unroll
        for (int bj = 0; bj < 2; ++bj) { const int c = u.pn * 256 + 128 * bj + 32 * wc + 8 * fq;
#pragma unroll
            for (int n = 0; n < 2; ++n) { const f32x4 g = *(const f32x4*)(gain + c + 4 * n); gi[bj][n] = (f32x4){1.f / g[0], 1.f / g[1], 1.f / g[2], 1.f / g[3]}; } }
#pragma unroll
        for (int ai = 0; ai < 2; ++ai)
#pragma unroll
            for (int m = 0; m < 4; ++m) {
                const int r = row0 + u.pm * 256 + ai * 128 + wr * 64 + m * 16 + fr;
                float ss = 0.f;
#pragma unroll
                for (int bj = 0; bj < 2; ++bj) {
                    const int c = u.pn * 256 + 128 * bj + 32 * wc + 8 * fq;
                    const u32x4 hw = *(const u32x4*)(h2 + (size_t)r * 1024 + c);
                    const f32x4 y0 = (f32x4){bflo(hw.x), bfhi(hw.x), bflo(hw.y), bfhi(hw.y)} * gi[bj][0] + acc[ai][bj][m][0], y1 = (f32x4){bflo(hw.z), bfhi(hw.z), bflo(hw.w), bfhi(hw.w)} * gi[bj][1] + acc[ai][bj][m][1];
                    *(u32x4*)(yb + (size_t)r * 1024 + c) = pack8(y0, y1);
                    ss += (y0[0] * y0[0] + y0[1] * y0[1]) + (y0[2] * y0[2] + y0[3] * y0[3]) + (y1[0] * y1[0] + y1[1] * y1[1]) + (y1[2] * y1[2] + y1[3] * y1[3]);
                }
                ss += __shfl_xor(ss, 16); ss += __shfl_xor(ss, 32);
                if (fq == 0) atomicAdd(rowsq + r, ss);
                asm volatile("" ::: "memory");
            }
    }
};

struct EpiUp {
    static constexpr bool PERM = true, AFTER_DRAIN = false;
    bf16_t* A; float *gs0, *gs1; const float *wconv, *bconv; float* out; const float* rowsq;
    __device__ __forceinline__ void operator()(const f32x4 (&acc)[2][2][4][2], const Unit& u, int wr, int wc, int fr, int fq) const {
        const int ch0 = 128 * u.pn + 32 * wc + 8 * fq;
        const int lane = fr + 16 * fq, src1 = (lane & 48) | ((fr + 15) & 15), src2 = (lane & 48) | ((fr + 14) & 15);
        float rs[2][4];
#pragma unroll
        for (int ai = 0; ai < 2; ++ai)
#pragma unroll
            for (int m = 0; m < 4; ++m) rs[ai][m] = rsqrtf(rowsq[u.pm * 256 + ai * 128 + wr * 64 + m * 16 + fr] * (1.f / 1024.f) + EPS);
#pragma unroll
        for (int n = 0; n < 2; ++n) {
            const int ch = ch0 + 4 * n;
            const f32x4 w0 = *(const f32x4*)(wconv + ch), w1 = *(const f32x4*)(wconv + DFF + ch), w2 = *(const f32x4*)(wconv + 2 * DFF + ch), bb = *(const f32x4*)(bconv + ch);
#pragma unroll
            for (int ai = 0; ai < 2; ++ai) {
                f32x4 pr1 = {0.f, 0.f, 0.f, 0.f}, pr2 = {0.f, 0.f, 0.f, 0.f};
#pragma unroll
                for (int m = 0; m < 4; ++m) {
                    const int r = u.pm * 256 + ai * 128 + wr * 64 + m * 16 + fr;
                    const f32x4 g = acc[ai][1][m][n] * rs[ai][m], uu = acc[ai][0][m][n] * rs[ai][m];
                    f32x4 R1, R2;
#pragma unroll
                    for (int e = 0; e < 4; ++e) { R1[e] = __shfl(g[e], src1); R2[e] = __shfl(g[e], src2); }
                    const f32x4 g1 = fr >= 1 ? R1 : pr1, g2 = fr >= 2 ? R2 : pr2;
                    pr1 = R1; pr2 = R2;
                    const f32x4 cv = bb + w0 * g2 + w1 * g1 + w2 * g;
                    f32x4 a;
#pragma unroll
                    for (int e = 0; e < 4; ++e) a[e] = cv[e] * __builtin_amdgcn_rcpf(1.f + __builtin_amdgcn_exp2f(-LOG2E * cv[e])) * uu[e];
                    const bool fix = (m == 0) && (fr < 2);
                    if (fix) a = uu;
                    u32x2 w; w.x = pk2(a[0], a[1]); w.y = pk2(a[2], a[3]);
                    *(u32x2*)(A + (size_t)r * DFF + ch) = w;
                    if (fix) *(f32x4*)(gs0 + (size_t)((r >> 6) * 2 + fr) * DFF + ch) = g;
                    if (m == 3 && fr >= 14) {
                        *(f32x4*)(gs1 + (size_t)((r >> 6) * 2 + (fr - 14)) * DFF + ch) = g;
                        if (r < MP) { if ((r & 4095) >= 4094) *(f32x4*)(out + O_CONVP + (size_t)((r >> 12) * 2 + (fr - 14)) * DFF + ch) = g; }
                        else *(f32x4*)(out + O_CONVS + (size_t)(((r - MP) >> 6) * 2 + (fr - 14)) * DFF + ch) = g;
                    }
                }
            }
        }
    }
};

constexpr int VPB = 144;
constexpr int ATT_KBYTES = 64 * (192 * 2 + 16);
constexpr int ATT_VBYTES = 128 * VPB;
constexpr int ATT_VOFF = 2 * ATT_KBYTES;
#define MFMA32(a, b, c) __builtin_amdgcn_mfma_f32_32x32x16_bf16((a), (b), (c), 0, 0, 0)

template <int DQK> __device__ __forceinline__ void att_load(const bf16_t* Kb, int kpitch, const bf16_t* Vb, int len, int kt, int tid, u32x4 (&kreg)[DQK / 64], u32x4 (&vreg)[2]) {
    constexpr int CPR = DQK / 8;
#pragma unroll
    for (int i = 0; i < DQK / 64; ++i) { const int p = tid + 512 * i, row = p / CPR, cp = p % CPR; kreg[i] = *(const u32x4*)(Kb + (size_t)(kt * 64 + row) * kpitch + cp * 8); }
#pragma unroll
    for (int i = 0; i < 2; ++i) { const int p = tid + 512 * i, row = p >> 3, cp = p & 7; vreg[i] = *(const u32x4*)(Vb + (size_t)row * len + kt * 64 + cp * 8); }
}
template <int DQK> __device__ __forceinline__ void att_store(LAS unsigned char* kbuf, LAS unsigned char* vbuf, int tid, const u32x4 (&kreg)[DQK / 64], const u32x4 (&vreg)[2]) {
    constexpr int CPR = DQK / 8, KP = DQK * 2 + 16;
#pragma unroll
    for (int i = 0; i < DQK / 64; ++i) { const int p = tid + 512 * i, row = p / CPR, cp = p % CPR; *(LAS u32x4*)(kbuf + row * KP + cp * 16) = kreg[i]; }
#pragma unroll
    for (int i = 0; i < 2; ++i) { const int p = tid + 512 * i, row = p >> 3, cp = p & 7; *(LAS u32x4*)(vbuf + row * VPB + cp * 16) = vreg[i]; }
}
template <int GS, int VAR> __device__ __forceinline__ void att_pv(f32x16 (&O)[4], const LAS unsigned char* vb, const bf16x8 (&pf)[4]) {
    bf16x8 va[2][GS];
    constexpr int NG = 16 / GS;
#pragma unroll
    for (int j = 0; j < GS; ++j) va[0][j] = *(const LAS bf16x8*)(vb + (j >> 2) * 32 * VPB + (j & 3) * 32);
#pragma unroll
    for (int g = 0; g < NG; ++g) {
        if (g + 1 < NG) {
#pragma unroll
            for (int j = 0; j < GS; ++j) { const int f = (g + 1) * GS + j; va[(g + 1) & 1][j] = *(const LAS bf16x8*)(vb + (f >> 2) * 32 * VPB + (f & 3) * 32); }
        }
#pragma unroll
        for (int j = 0; j < GS; ++j) { const int f = g * GS + j;
            if (VAR == 4) O[f >> 2][f & 3] += __builtin_bit_cast(f32x4, va[g & 1][j])[0] + __builtin_bit_cast(f32x4, pf[f & 3])[1];
            else O[f >> 2] = MFMA32(va[g & 1][j], pf[f & 3], O[f >> 2]); }
        __builtin_amdgcn_sched_barrier(0);
    }
}

template <int DQK, int VAR> __device__ __forceinline__ void att_tile(LAS unsigned char* lds, int kt, int mylast, int grp, bool& pend, int vs_prev, int vs_cur, int lane_off, int r, int h,
                                                            const bf16x8 (&qf)[DQK / 16], f32x16 (&O)[4], bf16x8 (&pf)[4], float& mrun, float& lrun) {
    constexpr int NS = DQK / 16, KP = DQK * 2 + 16;
    if (pend) { att_pv<(DQK == 64) ? 4 : 2, VAR>(O, lds + ATT_VOFF + vs_prev * ATT_VBYTES + lane_off, pf); pend = false; }
    if (kt <= mylast) {
        f32x16 S0, S1;
#pragma unroll
        for (int i = 0; i < 16; ++i) { S0[i] = 0.f; S1[i] = 0.f; }
        const LAS unsigned char* kb = lds + (kt & 1) * ATT_KBYTES + r * KP + h * 16;
        bf16x8 ka[3][2];
        ka[0][0] = *(const LAS bf16x8*)(kb); ka[0][1] = *(const LAS bf16x8*)(kb + 32 * KP);
        ka[1][0] = *(const LAS bf16x8*)(kb + 32); ka[1][1] = *(const LAS bf16x8*)(kb + 32 * KP + 32);
#pragma unroll
        for (int s = 0; s < NS; ++s) {
            if (s + 2 < NS) { ka[(s + 2) % 3][0] = *(const LAS bf16x8*)(kb + (s + 2) * 32); ka[(s + 2) % 3][1] = *(const LAS bf16x8*)(kb + 32 * KP + (s + 2) * 32); }
            if (VAR == 4) { S0[s & 15] += __builtin_bit_cast(f32x4, ka[s % 3][0])[0] * __builtin_bit_cast(f32x4, qf[s])[1]; S1[s & 15] += __builtin_bit_cast(f32x4, ka[s % 3][1])[2]; }
            else { S0 = MFMA32(ka[s % 3][0], qf[s], S0); S1 = MFMA32(ka[s % 3][1], qf[s], S1); }
            __builtin_amdgcn_sched_barrier(0);
        }
        if (VAR != 5) {
        float mx = S0[0];
#pragma unroll
        for (int i = 1; i < 16; ++i) mx = fmaxf(mx, S0[i]);
#pragma unroll
        for (int i = 0; i < 16; ++i) mx = fmaxf(mx, S1[i]);
        mx = fmaxf(mx, __shfl_xor(mx, 32));
        const float mn = fmaxf(mrun, mx), alpha = __builtin_amdgcn_exp2f(mrun - mn);
        const bool grew = __builtin_amdgcn_ballot_w64(mn > mrun) != 0ull;
        mrun = mn;
        float ps = 0.f;
#pragma unroll
        for (int i = 0; i < 16; ++i) { S0[i] = (VAR == 2) ? (S0[i] - mn) : __builtin_amdgcn_exp2f(S0[i] - mn); ps += S0[i]; }
#pragma unroll
        for (int i = 0; i < 16; ++i) { S1[i] = (VAR == 2) ? (S1[i] - mn) : __builtin_amdgcn_exp2f(S1[i] - mn); ps += S1[i]; }
        lrun = lrun * alpha + ps;
        if (grew) {
#pragma unroll
            for (int db = 0; db < 4; ++db) O[db] = O[db] * alpha;
        }
        } else lrun += S0[0];
        { u32x4 w;
          w.x = pk2(S0[0], S0[1]); w.y = pk2(S0[2], S0[3]); w.z = pk2(S0[4], S0[5]); w.w = pk2(S0[6], S0[7]); pf[0] = __builtin_bit_cast(bf16x8, w);
          w.x = pk2(S0[8], S0[9]); w.y = pk2(S0[10], S0[11]); w.z = pk2(S0[12], S0[13]); w.w = pk2(S0[14], S0[15]); pf[1] = __builtin_bit_cast(bf16x8, w);
          w.x = pk2(S1[0], S1[1]); w.y = pk2(S1[2], S1[3]); w.z = pk2(S1[4], S1[5]); w.w = pk2(S1[6], S1[7]); pf[2] = __builtin_bit_cast(bf16x8, w);
          w.x = pk2(S1[8], S1[9]); w.y = pk2(S1[10], S1[11]); w.z = pk2(S1[12], S1[13]); w.w = pk2(S1[14], S1[15]); pf[3] = __builtin_bit_cast(bf16x8, w); }
        if (grp == 0) att_pv<(DQK == 64) ? 4 : 2, VAR>(O, lds + ATT_VOFF + vs_cur * ATT_VBYTES + lane_off, pf);
        else pend = true;
    }
}

template <int DQK, int VAR> __device__ __forceinline__ void att_tile_fused(LAS unsigned char* lds, int kt, int mylast, bool& pend, int vs_prev, int vs_cur, int lane_off, int r, int h,
                                                                 const bf16x8 (&qf)[DQK / 16], f32x16 (&O)[4], bf16x8 (&pf)[4], float& mrun, float& lrun, float& alpha_p, bool& grew_p) {
    constexpr int KP = DQK * 2 + 16, NS = DQK / 16;
    if (grew_p) {
#pragma unroll
        for (int db = 0; db < 4; ++db) O[db] = O[db] * alpha_p;
        grew_p = false;
    }
    if (kt > mylast) {
        if (pend) { att_pv<4, VAR>(O, lds + ATT_VOFF + vs_prev * ATT_VBYTES + lane_off, pf); pend = false; }
        return;
    }
    f32x16 S0, S1;
#pragma unroll
    for (int i = 0; i < 16; ++i) { S0[i] = 0.f; S1[i] = 0.f; }
    const LAS unsigned char* kb = lds + (kt & 1) * ATT_KBYTES + r * KP + h * 16;
    bf16x8 ka[2][2];
    ka[0][0] = *(const LAS bf16x8*)(kb); ka[0][1] = *(const LAS bf16x8*)(kb + 32 * KP);
#pragma unroll
    for (int s = 0; s < NS; ++s) {
        if (s + 1 < NS) { ka[(s + 1) & 1][0] = *(const LAS bf16x8*)(kb + (s + 1) * 32); ka[(s + 1) & 1][1] = *(const LAS bf16x8*)(kb + 32 * KP + (s + 1) * 32); }
        S0 = MFMA32(ka[s & 1][0], qf[s], S0); S1 = MFMA32(ka[s & 1][1], qf[s], S1);
        __builtin_amdgcn_sched_barrier(0);
    }
    const LAS unsigned char* vb = lds + ATT_VOFF + (pend ? vs_prev : vs_cur) * ATT_VBYTES + lane_off;
    bf16x8 va[2][4];
#pragma unroll
    for (int js = 0; js < 4; ++js) va[0][js] = *(const LAS bf16x8*)(vb + js * 32);
    float mx = S0[0];
#pragma unroll
    for (int i = 1; i < 16; ++i) mx = fmaxf(mx, S0[i]);
#pragma unroll
    for (int i = 0; i < 16; ++i) mx = fmaxf(mx, S1[i]);
    mx = fmaxf(mx, __shfl_xor(mx, 32));
    const float mn = fmaxf(mrun, mx), alpha = __builtin_amdgcn_exp2f(mrun - mn);
    const bool grew = __builtin_amdgcn_ballot_w64(mn > mrun) != 0ull;
    mrun = mn;
    float ps = 0.f;
    u32x4 w0, w1, w2, w3;
    __builtin_amdgcn_sched_barrier(0);
#pragma unroll
    for (int db = 0; db < 4; ++db) {
        if (db < 3) {
#pragma unroll
            for (int js = 0; js < 4; ++js) va[(db + 1) & 1][js] = *(const LAS bf16x8*)(vb + (db + 1) * 32 * VPB + js * 32);
        }
#pragma unroll
        for (int js = 0; js < 4; ++js) {
            const int c = db * 4 + js;
            O[db] = MFMA32(va[db & 1][js], pf[js], O[db]);
            S0[c] = __builtin_amdgcn_exp2f(S0[c] - mn); S1[c] = __builtin_amdgcn_exp2f(S1[c] - mn); ps += S0[c] + S1[c];
            if (c & 1) {
                const unsigned a = pk2(S0[c - 1], S0[c]), b = pk2(S1[c - 1], S1[c]);
                const int q = c >> 1;
                if (q == 0) { w0.x = a; w2.x = b; } else if (q == 1) { w0.y = a; w2.y = b; } else if (q == 2) { w0.z = a; w2.z = b; } else if (q == 3) { w0.w = a; w2.w = b; }
                else if (q == 4) { w1.x = a; w3.x = b; } else if (q == 5) { w1.y = a; w3.y = b; } else if (q == 6) { w1.z = a; w3.z = b; } else { w1.w = a; w3.w = b; }
            }
            __builtin_amdgcn_sched_barrier(0);
        }
    }
    lrun = lrun * alpha + ps;
    alpha_p = alpha; grew_p = grew;
    pf[0] = __builtin_bit_cast(bf16x8, w0); pf[1] = __builtin_bit_cast(bf16x8, w1); pf[2] = __builtin_bit_cast(bf16x8, w2); pf[3] = __builtin_bit_cast(bf16x8, w3);
    pend = true;
}

template <int DQK, int VAR> __device__ __forceinline__ void attn_core(LAS unsigned char* lds, const bf16_t* Qrow, const bf16_t* Kb, int kpitch, const bf16_t* Vb, int len,
                                                             int ntiles, int mylast, int grp_in, f32x16 (&O)[4], int tid_in, int r_in, int h_in) {
    constexpr int NS = DQK / 16;
    constexpr bool PF2 = (DQK == 64);
    int tid = tid_in; asm volatile("" : "+v"(tid));
    const int r = tid & 31, h = (tid >> 5) & 1;
    const int grp = 0;
#define ATT_TILE(KT) do { if constexpr (DQK == 64 && VAR != 4 && VAR != 5) att_tile_fused<DQK, VAR>(lds, (KT), mylast, pend, vs_prev, vs_cur, lane_off, r, h, qf, O, pf, mrun, lrun, alpha_p, grew_p); \
        else att_tile<DQK, VAR>(lds, (KT), mylast, grp, pend, vs_prev, vs_cur, lane_off, r, h, qf, O, pf, mrun, lrun); } while (0)
    bf16x8 qf[NS];
#pragma unroll
    for (int s = 0; s < NS; ++s) qf[s] = (mylast >= 0) ? *(const bf16x8*)(Qrow + 16 * s + 8 * h) : (bf16x8){0, 0, 0, 0, 0, 0, 0, 0};
#pragma unroll
    for (int db = 0; db < 4; ++db)
#pragma unroll
        for (int i = 0; i < 16; ++i) O[db][i] = 0.f;
    float mrun = -1e30f, lrun = 0.f;
    bf16x8 pf[4];
#pragma unroll
    for (int j = 0; j < 4; ++j) pf[j] = (bf16x8){0, 0, 0, 0, 0, 0, 0, 0};
    int vs_prev = 2, vs_cur = 0, vs_next = 1;
    bool pend = false; float alpha_p = 1.f; bool grew_p = false;
    const int lane_off = r * VPB + h * 16;
    if constexpr (PF2) {
        u32x4 kA[DQK / 64], vA[2], kB[DQK / 64], vB[2];
        att_load<DQK>(Kb, kpitch, Vb, len, 0, tid, kA, vA);
        att_store<DQK>(lds, lds + ATT_VOFF, tid, kA, vA);
        if (VAR != 3 && ntiles > 1) att_load<DQK>(Kb, kpitch, Vb, len, 1, tid, kB, vB);
        __syncthreads();
        for (int kt = 0; kt < ntiles; kt += 2) {
            if (VAR != 3 && kt + 2 < ntiles) att_load<DQK>(Kb, kpitch, Vb, len, kt + 2, tid, kA, vA);
            ATT_TILE(kt);
            if (VAR != 3 && kt + 1 < ntiles) att_store<DQK>(lds + ((kt + 1) & 1) * ATT_KBYTES, lds + ATT_VOFF + vs_next * ATT_VBYTES, tid, kB, vB);
            __syncthreads();
            vs_prev = vs_cur; vs_cur = vs_next; vs_next = (vs_next == 2) ? 0 : vs_next + 1;
            if (kt + 1 < ntiles) {
                if (VAR != 3 && kt + 3 < ntiles) att_load<DQK>(Kb, kpitch, Vb, len, kt + 3, tid, kB, vB);
                ATT_TILE(kt + 1);
                if (VAR != 3 && kt + 2 < ntiles) att_store<DQK>(lds + (kt & 1) * ATT_KBYTES, lds + ATT_VOFF + vs_next * ATT_VBYTES, tid, kA, vA);
                __syncthreads();
                vs_prev = vs_cur; vs_cur = vs_next; vs_next = (vs_next == 2) ? 0 : vs_next + 1;
            }
        }
    } else {
        u32x4 kreg[DQK / 64], vreg[2];
        att_load<DQK>(Kb, kpitch, Vb, len, 0, tid, kreg, vreg);
        att_store<DQK>(lds, lds + ATT_VOFF, tid, kreg, vreg);
        __syncthreads();
        for (int kt = 0; kt < ntiles; ++kt) {
            const bool more = (kt + 1 < ntiles);
            if (more) att_load<DQK>(Kb, kpitch, Vb, len, kt + 1, tid, kreg, vreg);
            ATT_TILE(kt);
            if (more) att_store<DQK>(lds + ((kt + 1) & 1) * ATT_KBYTES, lds + ATT_VOFF + vs_next * ATT_VBYTES, tid, kreg, vreg);
            __syncthreads();
            vs_prev = vs_cur; vs_cur = vs_next; vs_next = (vs_next == 2) ? 0 : vs_next + 1;
        }
    }
    if (grew_p) {
#pragma unroll
        for (int db = 0; db < 4; ++db) O[db] = O[db] * alpha_p;
    }
    if (pend) att_pv<(DQK == 64) ? 4 : 2, VAR>(O, lds + ATT_VOFF + vs_prev * ATT_VBYTES + lane_off, pf);
    __syncthreads();
    const float lt = lrun + __shfl_xor(lrun, 32);
    const float inv = lt > 0.f ? 1.0f / lt : 0.f;
#pragma unroll
    for (int db = 0; db < 4; ++db) O[db] = O[db] * inv;
}

template <int VAR> __device__ __forceinline__ void attn_phase(LAS unsigned char* lds, const PTab& P, const int wid_s) {
    const int tid_ = phase_tid(wid_s);
    const int tid = tid_, wave = __builtin_amdgcn_readfirstlane(tid >> 6), lane = tid & 63, r = lane & 31, h = lane >> 5;
    unsigned char* ws = P.ws();
    const bf16_t* qd = (const bf16_t*)(ws + WS_QD); const bf16_t* kd = (const bf16_t*)(ws + WS_KD); const bf16_t* vtd = (const bf16_t*)(ws + WS_VTD);
    const bf16_t* qm = (const bf16_t*)(ws + WS_QM); const bf16_t* km = (const bf16_t*)(ws + WS_KM); const bf16_t* vtm = (const bf16_t*)(ws + WS_VTM);
    bf16_t* mix = (bf16_t*)(ws + WS_ACT);
    const float d1 = wave_sum(P.in(9)[lane] * P.in(10)[lane]), d2 = wave_sum(P.in(11)[lane] * P.in(12)[lane]);
    const float lam = __expf(d1) - __expf(d2) + LAM_INIT;
    const float* gsub = P.in(13);
    const int grp = (wave ^ (wave >> 2)) & 1;
    const int G = gridDim.x, c = blockIdx.x;
    constexpr int NPI = 2048, NITEMS = NPI + 64;
    const bool xcd_order = (G == 256);
    const int rounds = xcd_order ? 9 : (NITEMS + G - 1) / G;
    for (int it = 0; it < rounds; ++it) {
        int hh, ntiles, mylast, qrow, kroff, len;
        if (xcd_order) {
            const int x = c & 7, j = c >> 3;
            if (it < 8) {
                hh = (it & 1) ? 4 + (it >> 1) : (it >> 1);
                const int seq = 2 * x + (j >> 4), qb = ((it >> 1) & 1) ? 15 - (j & 15) : (j & 15);
                ntiles = 4 * qb + 4; mylast = 4 * qb + (wave >> 1); qrow = seq * 4096 + qb * 256 + 32 * wave + r; kroff = seq * 4096; len = SEQ;
            } else {
                if (j >= 8) continue;
                hh = j;
                ntiles = 17; mylast = wave < 2 ? 16 : -1; qrow = MP + x * 64 + 32 * (wave & 1) + r; kroff = MP + x * SLEN; len = SLEN;
            }
        } else {
            const int item = it * G + ((it & 1) ? (G - 1 - c) : c);
            if (item >= NITEMS) continue;
            if (item < NPI) {
                const int qb = 15 - (item >> 7), rem = item & 127, seq = rem >> 3; hh = rem & 7;
                ntiles = 4 * qb + 4; mylast = 4 * qb + (wave >> 1); qrow = seq * 4096 + qb * 256 + 32 * wave + r; kroff = seq * 4096; len = SEQ;
            } else {
                const int j = item - NPI, b = j >> 3; hh = j & 7;
                ntiles = 17; mylast = wave < 2 ? 16 : -1; qrow = MP + b * 64 + 32 * (wave & 1) + r; kroff = MP + b * SLEN; len = SLEN;
            }
        }
        if (VAR != 0 && VAR != 6 && hh >= 4) continue;
        if (VAR == 6 && it < 8) continue;
        const bool wr_ok = (VAR == 0) || (lam == 123456.789f);
        f32x16 O[4];
        asm volatile("" : "+v"(qrow));
        if (hh < 4) {
            attn_core<64, VAR>(lds, qd + (size_t)qrow * 512 + (2 * hh) * 64, kd + (size_t)kroff * 512 + (2 * hh) * 64, 512, vtd + (size_t)kroff * 512 + (size_t)(hh * 128) * len, len, ntiles, mylast, grp, O, tid, r, h);
            f32x4* o0s = (f32x4*)((float*)(ws + WS_O0) + ((size_t)blockIdx.x * 512 + tid) * 64);
#pragma unroll
            for (int db = 0; db < 4; ++db)
#pragma unroll
                for (int g4 = 0; g4 < 4; ++g4) o0s[db * 4 + g4] = (f32x4){O[db][4 * g4], O[db][4 * g4 + 1], O[db][4 * g4 + 2], O[db][4 * g4 + 3]};
            asm volatile("" : "+v"(qrow) :: "memory");
            attn_core<64, VAR>(lds, qd + (size_t)qrow * 512 + (2 * hh + 1) * 64, kd + (size_t)kroff * 512 + (2 * hh + 1) * 64, 512, vtd + (size_t)kroff * 512 + (size_t)(hh * 128) * len, len, ntiles, mylast, grp, O, tid, r, h);
            asm volatile("" : "+v"(qrow));
            if (mylast >= 0 && wr_ok) {
                float ss = 0.f;
#pragma unroll
                for (int db = 0; db < 4; ++db)
#pragma unroll
                    for (int g4 = 0; g4 < 4; ++g4) { const f32x4 p0 = o0s[db * 4 + g4];
#pragma unroll
                        for (int e = 0; e < 4; ++e) { const float o = p0[e] - lam * O[db][4 * g4 + e]; O[db][4 * g4 + e] = o; ss += o * o; } }
                ss += __shfl_xor(ss, 32);
                const float rs = rsqrtf(ss * (1.f / 128.f) + EPS) * (1.f - LAM_INIT);
                bf16_t* d = mix + (size_t)qrow * 1024 + hh * 128;
#pragma unroll
                for (int db = 0; db < 4; ++db)
#pragma unroll
                    for (int g4 = 0; g4 < 4; ++g4) {
                        const int dv = 32 * db + 8 * g4 + 4 * h;
                        const f32x4 gv = *(const f32x4*)(gsub + dv);
                        u32x2 w; w.x = pk2(O[db][4 * g4] * rs * gv[0], O[db][4 * g4 + 1] * rs * gv[1]); w.y = pk2(O[db][4 * g4 + 2] * rs * gv[2], O[db][4 * g4 + 3] * rs * gv[3]);
                        *(u32x2*)(d + dv) = w;
                    }
            }
        } else {
            const int hm = hh - 4;
            attn_core<192, VAR>(lds, qm + (size_t)qrow * 768 + hm * 192, km + (size_t)kroff * 768 + hm * 192, 768, vtm + (size_t)kroff * 512 + (size_t)(hm * 128) * len, len, ntiles, mylast, grp, O, tid, r, h);
            asm volatile("" : "+v"(qrow));
            if (mylast >= 0 && wr_ok) {
                bf16_t* d = mix + (size_t)qrow * 1024 + 512 + hm * 128;
#pragma unroll
                for (int db = 0; db < 4; ++db)
#pragma unroll
                    for (int g4 = 0; g4 < 4; ++g4) {
                        const int dv = 32 * db + 8 * g4 + 4 * h;
                        u32x2 w; w.x = pk2(O[db][4 * g4], O[db][4 * g4 + 1]); w.y = pk2(O[db][4 * g4 + 2], O[db][4 * g4 + 3]);
                        *(u32x2*)(d + dv) = w;
                    }
            }
        }
    }
}

template <int MODE> __device__ __forceinline__ int wmap(int np) {
    if (MODE == 0) { const int pn = np >> 8, j = np & 255, bj = j >> 7, wc = (j >> 5) & 3, i = j & 31; const int n = 256 * pn + 64 * wc + 32 * bj + i; return n < 1984 ? n : -1; }
    if (MODE == 1) { const int pn = np >> 8, j = np & 255; if (pn < 2) return 192 * (2 * pn + (j >> 7)) + (j & 127); const int bj = j >> 7, wc = (j >> 5) & 3, i = j & 31; return 192 * wc + 128 + 32 * bj + i; }
    if (MODE == 3) { const int pn = np >> 8, j = np & 255, bj = j >> 7, jj = j & 127; return bj * DFF + 128 * pn + jj; }
    return np;
}
template <int MODE> __device__ __forceinline__ void conv_w(const float* W, int K, int N, bf16_t* Wt, int NP, LAS float* scr, int gw, int ngw, int lane) {
    const int nblk = NP / 32, nitems = (K / 64) * nblk;
    for (int it = gw; it < nitems; it += ngw) {
        const int kb = it / nblk, nb = it % nblk, k0 = 64 * kb, np0 = 32 * nb, n0 = wmap<MODE>(np0);
#pragma unroll 8
        for (int i = 0; i < 32; ++i) { const int kk = 2 * i + (lane >> 5); scr[kk * 33 + (lane & 31)] = n0 >= 0 ? W[(size_t)(k0 + kk) * N + n0 + (lane & 31)] : 0.f; }
        asm volatile("s_waitcnt lgkmcnt(0)" ::: "memory");
        const int c = lane & 7;
#pragma unroll
        for (int j = 0; j < 4; ++j) { const int n = (lane >> 3) + 8 * j; const LAS float* sp = scr + (8 * c) * 33 + n;
            u32x4 o; o.x = pk2(sp[0 * 33], sp[1 * 33]); o.y = pk2(sp[2 * 33], sp[3 * 33]); o.z = pk2(sp[4 * 33], sp[5 * 33]); o.w = pk2(sp[6 * 33], sp[7 * 33]);
            *(u32x4*)(Wt + (size_t)(np0 + n) * K + k0 + 8 * c) = o; }
        asm volatile("s_waitcnt lgkmcnt(0)" ::: "memory");
    }
}
template <bool OUT_BF16> __device__ __forceinline__ void rms4(const float* x0, const float* g, void* o0, int lane) {
    const f32x4* g4 = (const f32x4*)g; f32x4 v[4][4];
#pragma unroll
    for (int i = 0; i < 4; ++i)
#pragma unroll
        for (int j = 0; j < 4; ++j) v[i][j] = __builtin_nontemporal_load(&((const f32x4*)(x0 + (size_t)i * 1024))[64 * j + lane]);
#pragma unroll
    for (int i = 0; i < 4; ++i) {
        float s = 0.f;
#pragma unroll
        for (int j = 0; j < 4; ++j) s += (v[i][j][0] * v[i][j][0] + v[i][j][1] * v[i][j][1]) + (v[i][j][2] * v[i][j][2] + v[i][j][3] * v[i][j][3]);
        const float rstd = rsqrtf(wave_sum(s) * (1.f / 1024.f) + EPS);
#pragma unroll
        for (int j = 0; j < 4; ++j) {
            const f32x4 o = v[i][j] * rstd * g4[64 * j + lane];
            if (OUT_BF16) { u32x2 w; w.x = pk2(o[0], o[1]); w.y = pk2(o[2], o[3]); *(u32x2*)((bf16_t*)o0 + (size_t)i * 1024 + 256 * j + 4 * lane) = w; }
            else ((f32x4*)((float*)o0 + (size_t)i * 1024))[64 * j + lane] = o;
        }
    }
}

__device__ __forceinline__ void phase0(LAS unsigned char* lds, const PTab& P, const int wid_s) {
    const int tid_ = phase_tid(wid_s);
    const int tid = tid_, wave = tid >> 6, lane = tid & 63;
    const int gtid = blockIdx.x * 512 + tid, gth = gridDim.x * 512, gw = blockIdx.x * 8 + wave, ngw = gridDim.x * 8;
    unsigned char* ws = P.ws();
    LAS float* scr = (LAS float*)(lds + wave * 16384);
    conv_w<0>(P.in(8), 1024, 1984, (bf16_t*)(ws + WS_WIN), 2048, scr, gw, ngw, lane);
    conv_w<1>(P.in(15), 256, 768, (bf16_t*)(ws + WS_WQB), 768, scr, gw, ngw, lane);
    conv_w<2>(P.in(17), 128, 1024, (bf16_t*)(ws + WS_WKVB), 1024, scr, gw, ngw, lane);
    conv_w<2>(P.in(18), 1024, 1024, (bf16_t*)(ws + WS_WOUT), 1024, scr, gw, ngw, lane);
    conv_w<3>(P.in(20), 1024, 5632, (bf16_t*)(ws + WS_WUP), 5632, scr, gw, ngw, lane);
    conv_w<2>(P.in(23), 2816, 1024, (bf16_t*)(ws + WS_WDN), 1024, scr, gw, ngw, lane);
    float* rope = (float*)(ws + WS_ROPE);
    { float* rsq = (float*)(ws + WS_RSQ); float* rsq2 = (float*)(ws + WS_RSQ2); float* rsqq = (float*)(ws + WS_RSQQ); for (int it = gtid; it < MT; it += gth) { rsq[it] = 0.f; rsq2[it] = 0.f; rsqq[it] = 0.f; } }
    for (int it = gtid; it < 4096 * 32; it += gth) {
        const int pos = it >> 5, i = it & 31;
        const float inv = (float)pow(10000.0, -(double)i * 0.03125);
        const float ang = (float)pos * inv;
        double rev = (double)ang * 0.15915494309189535; rev -= rint(rev);
        const float fr = (float)rev;
        rope[pos * 64 + i] = __builtin_amdgcn_cosf(fr); rope[pos * 64 + 32 + i] = __builtin_amdgcn_sinf(fr);
    }
    bf16_t* H = (bf16_t*)(ws + WS_ACT);
    { const float* xp = P.in(0); const float* xs = P.in(1); const float* ga = P.in(7);
      for (int r = 4 * gw; r < MT; r += 4 * ngw) rms4<true>(r < MP ? xp + (size_t)r * 1024 : xs + (size_t)(r - MP) * 1024, ga, H + (size_t)r * 1024, lane); }
    const float* cdk = P.in(2); const float* cdv = P.in(3); const float* cckv = P.in(4); const float* ckr = P.in(5);
    bf16_t* kd = (bf16_t*)(ws + WS_KD); bf16_t* vtd = (bf16_t*)(ws + WS_VTD); bf16_t* ckv = (bf16_t*)(ws + WS_CKV); bf16_t* km = (bf16_t*)(ws + WS_KM);
    for (int it = gtid; it < DBATCH * PAST * 64; it += gth) {
        const int c8 = it & 63, bp = it >> 6, b = bp >> 10, p = bp & 1023;
        const f32x4* s = (const f32x4*)(cdk + (size_t)bp * 512 + c8 * 8);
        *(u32x4*)(kd + (size_t)(MP + b * SLEN + p) * 512 + c8 * 8) = pack8(s[0], s[1]);
    }
    for (int it = gtid; it < DBATCH * (PAST / 16) * 512; it += gth) {
        const int col = it & 511, pblk = (it >> 9) & 63, b = it >> 15;
        const float* src = cdv + ((size_t)(b * PAST + pblk * 16)) * 512 + col;
        float v[16];
#pragma unroll
        for (int j = 0; j < 16; ++j) v[j] = src[(size_t)j * 512];
        u32x4 o0, o1;
        o0.x = pk2(v[0], v[1]); o0.y = pk2(v[2], v[3]); o0.z = pk2(v[8], v[9]); o0.w = pk2(v[10], v[11]);
        o1.x = pk2(v[4], v[5]); o1.y = pk2(v[6], v[7]); o1.z = pk2(v[12], v[13]); o1.w = pk2(v[14], v[15]);
        bf16_t* d = vtd + (size_t)(MP + b * SLEN) * 512 + (size_t)col * SLEN + pblk * 16;
        *(u32x4*)d = o0; *(u32x4*)(d + 8) = o1;
    }
    for (int it = gtid; it < DBATCH * PAST * 16; it += gth) {
        const int c8 = it & 15, bp = it >> 4, b = bp >> 10, p = bp & 1023;
        const f32x4* s = (const f32x4*)(cckv + (size_t)bp * 128 + c8 * 8);
        *(u32x4*)(ckv + (size_t)(MP + b * SLEN + p) * 128 + c8 * 8) = pack8(s[0], s[1]);
    }
    for (int it = gtid; it < DBATCH * PAST * 8; it += gth) {
        const int c8 = it & 7, bp = it >> 3, b = bp >> 10, p = bp & 1023;
        const f32x4* s = (const f32x4*)(ckr + (size_t)bp * 64 + c8 * 8);
        const u32x4 w = pack8(s[0], s[1]);
#pragma unroll
        for (int hh = 0; hh < 4; ++hh) *(u32x4*)(km + (size_t)(MP + b * SLEN + p) * 768 + hh * 192 + 128 + c8 * 8) = w;
    }
}

__device__ __forceinline__ void phase_lnorm(const PTab& P, const int wid_s) {
    const int tid_ = phase_tid(wid_s);
    const int tid = tid_, wave = tid >> 6, lane = tid & 63, gw = blockIdx.x * 8 + wave, ngw = gridDim.x * 8;
    unsigned char* ws = P.ws(); float* outp = P.out();
    const float* ckvraw = (const float*)(ws + WS_CKVRAW);
    bf16_t* ckv = (bf16_t*)(ws + WS_CKV);
    const f32x2_t gk = ((const f32x2_t*)P.in(16))[lane];
    for (int r0 = 8 * gw; r0 < MT; r0 += 8 * ngw) {
        f32x2_t k[8];
#pragma unroll
        for (int i = 0; i < 8; ++i) k[i] = ((const f32x2_t*)(ckvraw + (size_t)(r0 + i) * 128))[lane];
#pragma unroll
        for (int i = 0; i < 8; ++i) {
            const int r = r0 + i;
            const float s2 = wave_sum(k[i][0] * k[i][0] + k[i][1] * k[i][1]);
            const float rstd2 = rsqrtf(s2 * (1.f / 128.f) + EPS);
            const f32x2_t ko = k[i] * rstd2 * gk;
            int pos, kr, kl, len; tok_row(r, pos, kr, kl, len);
            *(f32x2_t*)(out_row(outp, r, O_CKVP, O_CKVS, 128) + 2 * lane) = ko;
            *(unsigned*)(ckv + (size_t)kr * 128 + 2 * lane) = pk2(ko[0], ko[1]);
        }
    }
}

__device__ __forceinline__ void phase_norm2(const PTab& P, const int wid_s) {
    const int tid_ = phase_tid(wid_s);
    const int tid = tid_, wave = tid >> 6, lane = tid & 63, gw = blockIdx.x * 8 + wave, ngw = gridDim.x * 8;
    bf16_t* H = (bf16_t*)(P.ws() + WS_ACT); const float* x1 = P.out(); const float* gf = P.in(19);
    for (int r = 4 * gw; r < MT; r += 4 * ngw) rms4<true>(x1 + (size_t)r * 1024, gf, H + (size_t)r * 1024, lane);
}

__device__ __forceinline__ void phase_conv(const PTab& P, const int wid_s) {
    const int tid_ = phase_tid(wid_s);
    const int gtid = blockIdx.x * 512 + tid_, gth = gridDim.x * 512;
    unsigned char* ws = P.ws();
    bf16_t* A = (bf16_t*)(ws + WS_U); const float* gs0 = (const float*)(ws + WS_GS0); const float* gs1 = (const float*)(ws + WS_GS1);
    const float* wconv = P.in(21); const float* bconv = P.in(22); const float* st = P.in(6);
    constexpr int C4 = DFF / 4, NIT = (MT / 64) * 2 * C4;
    for (int it = gtid; it < NIT; it += gth) {
        const int c4 = it % C4, bq = it / C4, q = bq & 1, b = bq >> 1, ch = 4 * c4, r = 64 * b + q;
        const bool prompt = b < (MP / 64), start = prompt ? ((b & 63) == 0) : true;
        const f32x4 zero = {0.f, 0.f, 0.f, 0.f};
        f32x4 p0 = zero, p1 = zero;
        if (!start) { p0 = *(const f32x4*)(gs1 + (size_t)((b - 1) * 2 + 0) * DFF + ch); p1 = *(const f32x4*)(gs1 + (size_t)((b - 1) * 2 + 1) * DFF + ch); }
        else if (!prompt) { const int sb = b - MP / 64; p0 = *(const f32x4*)(st + (size_t)(sb * 2 + 0) * DFF + ch); p1 = *(const f32x4*)(st + (size_t)(sb * 2 + 1) * DFF + ch); }
        const f32x4 g = *(const f32x4*)(gs0 + (size_t)(b * 2 + q) * DFF + ch);
        f32x4 g1, g2;
        if (q == 0) { g1 = p1; g2 = p0; } else { g1 = *(const f32x4*)(gs0 + (size_t)(b * 2) * DFF + ch); g2 = p1; }
        const f32x4 w0 = *(const f32x4*)(wconv + ch), w1 = *(const f32x4*)(wconv + DFF + ch), w2 = *(const f32x4*)(wconv + 2 * DFF + ch), bb = *(const f32x4*)(bconv + ch);
        const f32x4 cv = bb + w0 * g2 + w1 * g1 + w2 * g;
        const u32x2 uw = *(const u32x2*)(A + (size_t)r * DFF + ch);
        const f32x4 uu = {bflo(uw.x), bfhi(uw.x), bflo(uw.y), bfhi(uw.y)};
        f32x4 a;
#pragma unroll
        for (int e = 0; e < 4; ++e) a[e] = cv[e] / (1.f + __expf(-cv[e])) * uu[e];
        u32x2 w; w.x = pk2(a[0], a[1]); w.y = pk2(a[2], a[3]);
        *(u32x2*)(A + (size_t)r * DFF + ch) = w;
    }
}

__device__ __forceinline__ void final_items4(const bf16_t* yb, const float* rsq, const float* gfin, float* outp, int first, int stride, int limit) {
    u32x4 w[4];
#pragma unroll
    for (int k = 0; k < 4; ++k) { const int it = first + k * stride; if (it < limit) w[k] = __builtin_nontemporal_load((const u32x4*)(yb + (size_t)it * 8)); }
#pragma unroll
    for (int k = 0; k < 4; ++k) { const int it = first + k * stride; if (it < limit) {
        const int r = it >> 7, c = (it & 127) * 8;
        const float rs = rsqrtf(rsq[r] * (1.f / 1024.f) + EPS);
        const f32x4 g0 = *(const f32x4*)(gfin + c), g1 = *(const f32x4*)(gfin + c + 4);
        const f32x4 y0 = (f32x4){bflo(w[k].x), bfhi(w[k].x), bflo(w[k].y), bfhi(w[k].y)} * rs * g0, y1 = (f32x4){bflo(w[k].z), bfhi(w[k].z), bflo(w[k].w), bfhi(w[k].w)} * rs * g1;
        __builtin_nontemporal_store(y0, (f32x4*)(outp + (size_t)it * 8)); __builtin_nontemporal_store(y1, (f32x4*)(outp + (size_t)it * 8 + 4)); } }
}
__device__ __forceinline__ void phase_final_prompt(LAS unsigned char* lds, const PTab& P, const int wid_s) {
    const int tid = phase_tid(wid_s);
    unsigned char* ws = P.ws();
    const bf16_t* yb = (const bf16_t*)(ws + WS_ACT); const float* rsq = (const float*)(ws + WS_RSQ2); const float* gfin = P.in(24); float* outp = P.out();
    unsigned* ctr = (unsigned*)ws + 3600;
    volatile LAS unsigned* slot = (volatile LAS unsigned*)(lds + PARAM_OFF + 272);
    constexpr int NCH = MP / 64, CH_ITEMS = 64 * 128;
    for (;;) {
        if (tid == 0) slot[0] = atomicAdd(ctr, 1u);
        __syncthreads();
        const unsigned idx = slot[0];
        __syncthreads();
        if (idx >= (unsigned)NCH) break;
        const int base = (int)idx * CH_ITEMS;
#pragma unroll 1
        for (int g = 0; g < 4; ++g) final_items4(yb, rsq, gfin, outp, base + tid + g * 2048, 512, base + CH_ITEMS);
    }
}
__device__ __forceinline__ void phase_final_sample(const PTab& P, const int wid_s) {
    const int tid_ = phase_tid(wid_s);
    const int gtid = blockIdx.x * 512 + tid_, gth = gridDim.x * 512;
    unsigned char* ws = P.ws();
    const bf16_t* yb = (const bf16_t*)(ws + WS_ACT); const float* rsq = (const float*)(ws + WS_RSQ2); const float* gfin = P.in(24); float* outp = P.out();
    for (int it0 = MP * 128 + gtid; it0 < MT * 128; it0 += 4 * gth) final_items4(yb, rsq, gfin, outp, it0, gth, MT * 128);
}

#define XB_TMO      128
#define XB_XCNT(j)  (256  + 64 * (j))
#define XB_XSUB(j)  (1280 + 64 * (j))
#define XB_XGEN(j)  (2304 + 64 * (j))
#define XB_TOP      3328
#define XB_TOPGEN   3392
#define XB_SPIN_CAP (1u << 18)
__device__ __forceinline__ unsigned xb_ld(unsigned* p)              { return __hip_atomic_load(p, __ATOMIC_RELAXED, __HIP_MEMORY_SCOPE_AGENT); }
__device__ __forceinline__ unsigned xb_add(unsigned* p, unsigned v) { return __hip_atomic_fetch_add(p, v, __ATOMIC_RELAXED, __HIP_MEMORY_SCOPE_AGENT); }
__device__ __forceinline__ unsigned xb_xcc_id() { return (unsigned)__builtin_amdgcn_s_getreg((3 << 11) | 20) & 0xFu; }
#define XB_SPIN(cond, bar) do { unsigned _sp = 0; while (cond) { __builtin_amdgcn_s_sleep(1); \
    if ((++_sp & 255u) == 0u) { if (xb_ld(&(bar)[XB_TMO])) break; if (_sp > XB_SPIN_CAP) { atomicAdd(&(bar)[XB_TMO], 1u); break; } } } } while (0)
__device__ __forceinline__ void xcd_barrier_complete(unsigned* bar, unsigned x, unsigned& nloc, unsigned& nx) {
    const unsigned G = gridDim.x;
    unsigned sum, cnt, mine, sp = 0u;
    for (;;) {
        sum = 0u; cnt = 0u; mine = 0u;
#pragma unroll
        for (unsigned j = 0; j < 16; ++j) { const unsigned c = xb_ld(&bar[XB_XCNT(j)]); sum += c; cnt += (c > 0u) ? 1u : 0u; mine = (j == x) ? c : mine; }
        if (sum == G) break;
        __builtin_amdgcn_s_sleep(1);
        if ((++sp & 255u) == 0u) { if (xb_ld(&bar[XB_TMO])) break; if (sp > XB_SPIN_CAP) { atomicAdd(&bar[XB_TMO], 1u); break; } }
    }
    nloc = mine > 0u ? mine : 1u; nx = cnt > 0u ? cnt : 1u;
}
__device__ __forceinline__ void xcd_barrier(unsigned* bar, const unsigned x, volatile LAS unsigned* st, const bool leader) {
    asm volatile("s_waitcnt vmcnt(0)" ::: "memory");
    __syncthreads();
    if (leader) {
        __builtin_amdgcn_s_waitcnt(0);
        unsigned nloc = st[0], nx = st[1];
        if (nloc == 0u) { xcd_barrier_complete(bar, x, nloc, nx); st[0] = nloc; st[1] = nx; }
        const unsigned old = xb_add(&bar[XB_XSUB(x)], 1u);
        const unsigned gen = old / nloc;
        if (old + 1u == (gen + 1u) * nloc) {
            __builtin_amdgcn_fence(__ATOMIC_RELEASE, "agent");
            asm volatile("s_waitcnt vmcnt(0)" ::: "memory");
            const unsigned og = xb_add(&bar[XB_TOP], 1u);
            const unsigned tg = og / nx;
            if (og + 1u == (tg + 1u) * nx) xb_add(&bar[XB_TOPGEN], 1u);
            else XB_SPIN(xb_ld(&bar[XB_TOPGEN]) == tg, bar);
            __builtin_amdgcn_fence(__ATOMIC_ACQUIRE, "agent");
            xb_add(&bar[XB_XGEN(x)], 1u);
            asm volatile("s_waitcnt vmcnt(0)" ::: "memory");
        } else {
            XB_SPIN(xb_ld(&bar[XB_XGEN(x)]) == gen, bar);
            __builtin_amdgcn_fence(__ATOMIC_ACQUIRE, "agent");
            asm volatile("s_waitcnt vmcnt(0)" ::: "memory");
        }
    }
    __syncthreads();
}

#ifndef MK_STOP
#define MK_STOP 99
#endif
#ifndef MK_MASK
#define MK_MASK 0xffff
#endif
#ifndef MK_DUP
#define MK_DUP 0
#endif
#ifndef MK_NOVT
#define MK_NOVT 0
#endif
#define PH(k) if ((MK_MASK >> (k)) & 1)
__global__ void __launch_bounds__(512, 2) fwd_kernel(Params KP) {
    extern __shared__ __attribute__((aligned(16))) unsigned char lds_raw[];
    LAS unsigned char* lds = (LAS unsigned char*)lds_raw;
    cg::grid_group grid = cg::this_grid();
    if (threadIdx.x == 0) {
        LAS unsigned long long* t = (LAS unsigned long long*)(lds + PARAM_OFF);
#pragma unroll
        for (int k = 0; k < 25; ++k) t[k] = (unsigned long long)KP.in[k];
        t[25] = (unsigned long long)KP.out; t[26] = (unsigned long long)KP.ws;
        ((volatile LAS unsigned*)(lds + PARAM_OFF + 256))[0] = 0u; ((volatile LAS unsigned*)(lds + PARAM_OFF + 256))[1] = 0u;
        (void)xb_add(&((unsigned*)KP.ws)[XB_XCNT(xb_xcc_id())], 1u);
    }
    __syncthreads();
    PTab P{lds};
    const int wid_s = __builtin_amdgcn_readfirstlane(threadIdx.x >> 6);
    const unsigned xcc = xb_xcc_id();
#define GRID_BAR() xcd_barrier((unsigned*)P.ws(), xcc, (volatile LAS unsigned*)(lds + PARAM_OFF + 256), phase_tid(wid_s) == 0)
    const int G = gridDim.x, c = blockIdx.x;
    PH(0) phase0(lds, P, wid_s);
    if (MK_DUP & 1) phase0(lds, P, wid_s);
    if (gridDim.x == 0x7fffffffu) grid.sync();
    GRID_BAR();
    if (MK_STOP <= 0) return;
    PH(1) {
        unsigned char* ws = P.ws();
        pg8::Gemm g{(const bf16_t*)(ws + WS_ACT), (const bf16_t*)(ws + WS_WIN), MT, 2048, 1024}; pg8::StaticOrder S; S.init(MT, 2048, G, c);
        EpiIn E{P.out(), (bf16_t*)(ws + WS_QD), (bf16_t*)(ws + WS_KD), (bf16_t*)(ws + WS_VTD), (bf16_t*)(ws + WS_KM), (float*)(ws + WS_CQRAW), (float*)(ws + WS_CKVRAW), (const float*)(ws + WS_ROPE), 0, (bf16_t*)(ws + WS_CQ), P.in(14), (float*)(ws + WS_RSQQ)};
        pg8::gemm_phase<EpiIn, pg8::StaticOrder, true, true>(lds, g, S, E, phase_tid(wid_s));
    }
    if (MK_DUP & (1 << 1)) {
        unsigned char* ws = P.ws();
        pg8::Gemm g{(const bf16_t*)(ws + WS_ACT), (const bf16_t*)(ws + WS_WIN), MT, 2048, 1024}; pg8::StaticOrder S; S.init(MT, 2048, G, c);
        EpiIn E{P.out(), (bf16_t*)(ws + WS_QD), (bf16_t*)(ws + WS_KD), (bf16_t*)(ws + WS_VTD), (bf16_t*)(ws + WS_KM), (float*)(ws + WS_CQRAW), (float*)(ws + WS_CKVRAW), (const float*)(ws + WS_ROPE), MK_NOVT, (bf16_t*)(ws + WS_CQ), P.in(14), (float*)(ws + WS_RSQQ)};
        pg8::gemm_phase<EpiIn, pg8::StaticOrder, true, true>(lds, g, S, E, phase_tid(wid_s));
    }
    GRID_BAR();
    if (MK_STOP <= 1) return;
    PH(2) phase_lnorm(P, wid_s);
    if (MK_DUP & 4) phase_lnorm(P, wid_s);
    GRID_BAR();
    if (MK_STOP <= 2) return;
    PH(3) {
        unsigned char* ws = P.ws();
        pg8::Gemm g{(const bf16_t*)(ws + WS_CQ), (const bf16_t*)(ws + WS_WQB), MT, 768, 256}; pg8::StaticOrder S; S.init(MT, 768, G, c);
        EpiQm E{(bf16_t*)(ws + WS_QM), (const float*)(ws + WS_ROPE), (const float*)(ws + WS_RSQQ)};
        pg8::gemm_phase<EpiQm, pg8::StaticOrder, true, true>(lds, g, S, E, phase_tid(wid_s));
    }
    if (MK_DUP & (1 << 3)) {
        unsigned char* ws = P.ws();
        pg8::Gemm g{(const bf16_t*)(ws + WS_CQ), (const bf16_t*)(ws + WS_WQB), MT, 768, 256}; pg8::StaticOrder S; S.init(MT, 768, G, c);
        EpiQm E{(bf16_t*)(ws + WS_QM), (const float*)(ws + WS_ROPE), (const float*)(ws + WS_RSQQ)};
        pg8::gemm_phase<EpiQm, pg8::StaticOrder, true, true>(lds, g, S, E, phase_tid(wid_s));
    }
    PH(4) {
        unsigned char* ws = P.ws();
        pg8::Gemm g{(const bf16_t*)(ws + WS_CKV), (const bf16_t*)(ws + WS_WKVB), KR, 1024, 128}; pg8::StaticOrder S; S.init(KR, 1024, G, c);
        EpiKv E{(bf16_t*)(ws + WS_KM), (bf16_t*)(ws + WS_VTM)};
        pg8::gemm_phase<EpiKv, pg8::StaticOrder, true, true>(lds, g, S, E, phase_tid(wid_s));
    }
    if (MK_DUP & (1 << 4)) {
        unsigned char* ws = P.ws();
        pg8::Gemm g{(const bf16_t*)(ws + WS_CKV), (const bf16_t*)(ws + WS_WKVB), KR, 1024, 128}; pg8::StaticOrder S; S.init(KR, 1024, G, c);
        EpiKv E{(bf16_t*)(ws + WS_KM), (bf16_t*)(ws + WS_VTM)};
        pg8::gemm_phase<EpiKv, pg8::StaticOrder, true, true>(lds, g, S, E, phase_tid(wid_s));
    }
    GRID_BAR();
    if (MK_STOP <= 3) return;
    PH(5) attn_phase<0>(lds, P, wid_s);
#ifdef MK_AVAR
    __syncthreads(); attn_phase<MK_AVAR>(lds, P, wid_s);
#endif
    GRID_BAR();
    if (MK_STOP <= 4) return;
    PH(6) {
        unsigned char* ws = P.ws();
        pg8::Gemm g{(const bf16_t*)(ws + WS_ACT), (const bf16_t*)(ws + WS_WOUT), MT, 1024, 1024}; pg8::StaticOrder S; S.init(MT, 1024, G, c);
        EpiOut E{P.in(0), P.in(1), (bf16_t*)(ws + WS_H2), P.in(19), (float*)(ws + WS_RSQ)};
        pg8::gemm_phase<EpiOut, pg8::StaticOrder, true, true>(lds, g, S, E, phase_tid(wid_s));
    }
    if (MK_DUP & (1 << 6)) {
        unsigned char* ws = P.ws();
        pg8::Gemm g{(const bf16_t*)(ws + WS_ACT), (const bf16_t*)(ws + WS_WOUT), MT, 1024, 1024}; pg8::StaticOrder S; S.init(MT, 1024, G, c);
        EpiOut E{P.in(0), P.in(1), (bf16_t*)(ws + WS_H2), P.in(19), (float*)(ws + WS_RSQ)};
        pg8::gemm_phase<EpiOut, pg8::StaticOrder, true, true>(lds, g, S, E, phase_tid(wid_s));
    }
    GRID_BAR();
    PH(8) {
        unsigned char* ws = P.ws();
        pg8::Gemm g{(const bf16_t*)(ws + WS_H2), (const bf16_t*)(ws + WS_WUP), MT, 5632, 1024}; pg8::StaticOrder S; S.init(MT, 5632, G, c);
        EpiUp E{(bf16_t*)(ws + WS_U), (float*)(ws + WS_GS0), (float*)(ws + WS_GS1), P.in(21), P.in(22), P.out(), (const float*)(ws + WS_RSQ)};
        pg8::gemm_phase<EpiUp, pg8::StaticOrder, true, true>(lds, g, S, E, phase_tid(wid_s));
    }
    if (MK_DUP & (1 << 8)) {
        unsigned char* ws = P.ws();
        pg8::Gemm g{(const bf16_t*)(ws + WS_H2), (const bf16_t*)(ws + WS_WUP), MT, 5632, 1024}; pg8::StaticOrder S; S.init(MT, 5632, G, c);
        EpiUp E{(bf16_t*)(ws + WS_U), (float*)(ws + WS_GS0), (float*)(ws + WS_GS1), P.in(21), P.in(22), P.out(), (const float*)(ws + WS_RSQ)};
        pg8::gemm_phase<EpiUp, pg8::StaticOrder, true, true>(lds, g, S, E, phase_tid(wid_s));
    }
    GRID_BAR();
    PH(9) phase_conv(P, wid_s);
    GRID_BAR();
    PH(10) {
        unsigned char* ws = P.ws();
        pg8::Gemm g{(const bf16_t*)(ws + WS_U), (const bf16_t*)(ws + WS_WDN), MP, 1024, 2816}; RevOrder S; S.init(MP, 1024, G, c);
        EpiDown E{(const bf16_t*)(ws + WS_H2), P.in(19), (bf16_t*)(ws + WS_ACT), (float*)(ws + WS_RSQ2), 0};
        pg8::gemm_phase<EpiDown, RevOrder, true, true>(lds, g, S, E, phase_tid(wid_s));
    }
    GRID_BAR();
    PH(11) {
        unsigned char* ws = P.ws();
        pg8::Gemm g{(const bf16_t*)(ws + WS_U) + (size_t)MP * 2816, (const bf16_t*)(ws + WS_WDN), MS, 1024, 2816}; pg8::StaticOrder S; S.init(MS, 1024, G, c);
        EpiDown E{(const bf16_t*)(ws + WS_H2), P.in(19), (bf16_t*)(ws + WS_ACT), (float*)(ws + WS_RSQ2), MP};
        pg8::gemm_phase<EpiDown, pg8::StaticOrder, true, true>(lds, g, S, E, phase_tid(wid_s));
    }
    PH(11) phase_final_prompt(lds, P, wid_s);
    GRID_BAR();
    PH(11) phase_final_sample(P, wid_s);
#ifdef MK_XSYNC
    for (int k = 0; k < MK_XSYNC; ++k) GRID_BAR();
#endif
}
}

extern "C" void kernel_launch(void* const* d_in, const int* in_sizes, int n_in, void* d_out, int out_size, void* d_ws, size_t ws_size, hipStream_t stream) {
    static int grid = 0;
    if (grid == 0) {
        if (n_in != 25 || (size_t)out_size != mk::O_TOTAL || ws_size < mk::WS_NEED) {
            fprintf(stderr, "kernel_launch: unexpected shapes (n_in %d, out %d, ws %zu, need %zu); nothing launched\n", n_in, out_size, ws_size, (size_t)mk::WS_NEED); grid = -1; return; }
        int dev = 0, cus = 0, per_cu = 0;
        hipGetDevice(&dev);
        hipDeviceGetAttribute(&cus, hipDeviceAttributeMultiprocessorCount, dev);
        hipFuncSetAttribute((const void*)mk::fwd_kernel, hipFuncAttributeMaxDynamicSharedMemorySize, mk::LDS_BYTES);
        hipOccupancyMaxActiveBlocksPerMultiprocessor(&per_cu, (const void*)mk::fwd_kernel, 512, mk::LDS_BYTES);
        if (per_cu < 1) { fprintf(stderr, "kernel_launch: occupancy query says %d blocks per CU\n", per_cu); per_cu = 1; }
        (void)hipGetLastError();
        grid = cus < 256 ? cus : 256;
    }
    if (grid < 0) return;
    if (hipMemsetAsync(d_ws, 0, mk::WS_BAR_BYTES, stream) != hipSuccess) { fprintf(stderr, "kernel_launch: memset of the barrier words failed\n"); return; }
    mk::Params p{};
    for (int i = 0; i < 25; ++i) p.in[i] = (const float*)d_in[i];
    p.out = (float*)d_out; p.ws = (unsigned char*)d_ws;
    void* args[] = {&p};
    hipError_t e = hipLaunchCooperativeKernel((const void*)mk::fwd_kernel, dim3(grid), dim3(512), args, mk::LDS_BYTES, stream);
    if (e != hipSuccess) fprintf(stderr, "cooperative launch failed: %s (grid %d)\n", hipGetErrorString(e), grid);
}
```

```cpp
#include <hip/hip_runtime.h>
#include <hip/hip_cooperative_groups.h>
#include <cstdio>
#include <cstdint>
namespace cg = cooperative_groups;
namespace pg8 {
#define PG8_LAS __attribute__((address_space(3)))
typedef unsigned short bf16_t;
typedef short bf16x8 __attribute__((ext_vector_type(8)));
typedef float f32x4 __attribute__((ext_vector_type(4)));
typedef unsigned u32x4 __attribute__((ext_vector_type(4)));
constexpr int BM = 256, BK = 64, HALF = 128, HTB = HALF * BK * 2  , STAGE_BYTES = 8 * HTB, NXCD = 8, WGM = 8;

__host__ __device__ __forceinline__ int lds_byte(int r, int c) { const int st = (r >> 4) * 2 + (c >> 5), rr = r & 15, cc = c & 31, ob = rr * 64 + cc * 2; return st * 1024 + (ob ^ (((ob >> 9) & 1) << 5)); }
__host__ __device__ __forceinline__ void stage_rc(int b, int& R, int& C) { const int st = b / 1024, sb = b % 1024, swz = sb ^ (((sb >> 9) & 1) << 5); R = (st >> 1) * 16 + swz / 64; C = (st & 1) * 32 + (swz % 64) / 2; }
__host__ __device__ __forceinline__ int perm32(int rho) { const int n = rho >> 4, i = rho & 15; return 8 * (i >> 2) + 4 * n + (i & 3); }

struct Unit { int pm, pn; };
struct Gemm { const bf16_t* A; const bf16_t* Bt; int M, N, K; };
struct StaticOrder {
    int nM, nN, nwg, G, c;
    __host__ __device__ void init(int M, int N, int G_, int c_) { nM = M / BM; nN = N / BM; nwg = nM * nN; G = G_; c = c_; }
    __host__ __device__ bool next(int i, Unit& u) const {
        const long L = (long)i * G + c; if (L >= nwg) return false;
        int wgid = (int)L; { const int q = nwg / NXCD, r = nwg % NXCD, xcd = wgid % NXCD, off = wgid / NXCD; wgid = (xcd < r ? xcd * (q + 1) : r * (q + 1) + (xcd - r) * q) + off; }
        const int nig = WGM * nN, gid = wgid / nig, fm = gid * WGM, gsz = (nM - fm) < WGM ? (nM - fm) : WGM;
        u.pm = fm + ((wgid % nig) % gsz); u.pn = (wgid % nig) / gsz; return true;
    }
    __device__ __forceinline__ void a_ready(const Unit&) const {}
    __device__ __forceinline__ void done(const Unit&) const {}
};
__device__ __forceinline__ unsigned cvt_pk_bf16(float lo, float hi) { unsigned r; asm volatile("v_cvt_pk_bf16_f32 %0, %1, %2" : "=v"(r) : "v"(lo), "v"(hi)); return r; }
typedef float f32x2 __attribute__((ext_vector_type(2)));
template <class Epi, class Sched, bool ALIGN_EPI = false, bool SP2 = false>
__device__ __forceinline__ void gemm_phase(PG8_LAS unsigned char* lds, const Gemm g, const Sched& S, const Epi& E, const int tid_in) {
    const int tid = tid_in;
    const int wid = __builtin_amdgcn_readfirstlane(tid >> 6), lane = tid & 63, wr = wid >> 2, wc = wid & 3, fr = lane & 15, fq = lane >> 4;
    const int K = g.K, nt = K / BK;
    unsigned voffA[2], voffB[2];
#pragma unroll
    for (int i = 0; i < 2; ++i) { int R, C; stage_rc(tid * 16 + i * 8192, R, C); const int Rb = Epi::PERM ? ((R & ~31) + perm32(R & 31)) : R;
        voffA[i] = (unsigned)(R * K + C) * 2u; voffB[i] = (unsigned)(Rb * K + C) * 2u; }
    const size_t kstep = (size_t)(BK * 2);
    const size_t hstep = (size_t)HALF * K * 2;
    const size_t tstep = 2 * hstep;
    const unsigned ldsw = (unsigned)wid * 1024u;
    const int aoff = lds_byte(wr * 64 + fr, fq * 8), boff = lds_byte(wc * 32 + fr, fq * 8);
#define PG8_SA(b, h) (((b) * 2 + (h)) * HTB)
#define PG8_SB(b, h) ((4 + (b) * 2 + (h)) * HTB)
#define PG8_STAGE(bufoff, gbase, voff) do { _Pragma("unroll") for (int _i = 0; _i < 2; ++_i) \
        __builtin_amdgcn_global_load_lds((const unsigned*)((const char*)(gbase) + (voff)[_i]), (PG8_LAS unsigned*)(lds + (bufoff) + ldsw + _i * 8192), 16, 0, 0); } while (0)
#define PG8_LDA(dst, b, h) do { _Pragma("unroll") for (int m = 0; m < 4; ++m) _Pragma("unroll") for (int k = 0; k < 2; ++k) dst[m][k] = *(const PG8_LAS bf16x8*)(lds + PG8_SA(b, h) + aoff + m * 2048 + k * 1024); } while (0)
#define PG8_LDB(dst, b, h) do { _Pragma("unroll") for (int n = 0; n < 2; ++n) _Pragma("unroll") for (int k = 0; k < 2; ++k) dst[n][k] = *(const PG8_LAS bf16x8*)(lds + PG8_SB(b, h) + boff + n * 2048 + k * 1024); } while (0)
#define PG8_MMA(ai, bj, At, Bt) do { __builtin_amdgcn_s_setprio(1); _Pragma("unroll") for (int m = 0; m < 4; ++m) _Pragma("unroll") for (int n = 0; n < 2; ++n) _Pragma("unroll") for (int k = 0; k < 2; ++k) \
        acc[ai][bj][m][n] = __builtin_amdgcn_mfma_f32_16x16x32_bf16(Bt[n][k], At[m][k], acc[ai][bj][m][n], 0, 0, 0); __builtin_amdgcn_s_setprio(0); } while (0)
#define PG8_WAIT_V(n) asm volatile("s_waitcnt vmcnt(" #n ")" ::: "memory")
#define PG8_WAIT_L(n) asm volatile("s_waitcnt lgkmcnt(" #n ")" ::: "memory")
#define PG8_BAR __builtin_amdgcn_s_barrier()
#define PG8_SCHED __builtin_amdgcn_sched_barrier(0)
    Unit cur, nxt; int ui = 0;
    if (!S.next(0, cur)) return;
    f32x4 acc[2][2][4][2];
#pragma unroll
    for (int a = 0; a < 2; ++a)
#pragma unroll
        for (int b = 0; b < 2; ++b)
#pragma unroll
            for (int m = 0; m < 4; ++m)
#pragma unroll
                for (int n = 0; n < 2; ++n) acc[a][b][m][n] = (f32x4){0.f, 0.f, 0.f, 0.f};
    bf16x8 At[4][2], B0[2][2], B1[2][2];
    const char* cA = (const char*)g.A + (size_t)cur.pm * tstep; const char* cB = (const char*)g.Bt + (size_t)cur.pn * tstep;
    S.a_ready(cur);
    if constexpr (SP2) {
        PG8_STAGE(PG8_SB(0, 0), cB, voffB); PG8_STAGE(PG8_SB(0, 1), cB + hstep, voffB); PG8_STAGE(PG8_SA(0, 0), cA, voffA); PG8_STAGE(PG8_SA(0, 1), cA + hstep, voffA);
        if (wr == 1) PG8_BAR;
        PG8_WAIT_V(2); PG8_BAR;
        PG8_STAGE(PG8_SB(1, 0), cB + kstep, voffB); PG8_STAGE(PG8_SA(1, 0), cA + kstep, voffA); PG8_STAGE(PG8_SB(1, 1), cB + hstep + kstep, voffB);
        PG8_WAIT_V(6); PG8_BAR;
    } else {
        PG8_STAGE(PG8_SB(0, 0), cB, voffB); PG8_STAGE(PG8_SA(0, 0), cA, voffA); PG8_STAGE(PG8_SB(0, 1), cB + hstep, voffB); PG8_STAGE(PG8_SA(0, 1), cA + hstep, voffA);
        if (wr == 1) PG8_BAR;
        PG8_WAIT_V(4); PG8_BAR;
        PG8_STAGE(PG8_SB(1, 0), cB + kstep, voffB); PG8_STAGE(PG8_SA(1, 0), cA + kstep, voffA); PG8_STAGE(PG8_SB(1, 1), cB + hstep + kstep, voffB);
        PG8_WAIT_V(6); PG8_BAR;
    }
    for (;;) {
        const bool has_next = S.next(ui + 1, nxt);
        const char* nA = has_next ? (const char*)g.A + (size_t)nxt.pm * tstep : cA; const char* nB = has_next ? (const char*)g.Bt + (size_t)nxt.pn * tstep : cB;
        for (int t = 0; t < nt; t += 2) {
            const bool last = (t == nt - 2);
            const char* a1 = cA + (size_t)(t + 1) * kstep;
            const char* a2 = last ? nA : cA + (size_t)(t + 2) * kstep; const char* b2 = last ? nB : cB + (size_t)(t + 2) * kstep;
            const char* a3 = a2 + kstep; const char* b3 = b2 + kstep;
            if (last && has_next) S.a_ready(nxt);
            if constexpr (SP2) {
            PG8_LDB(B0, 0, 0); PG8_LDB(B1, 0, 1); PG8_SCHED; PG8_LDA(At, 0, 0); PG8_STAGE(PG8_SA(1, 1), a1 + hstep, voffA);
            PG8_WAIT_V(8); PG8_WAIT_L(0); PG8_BAR; PG8_MMA(0, 0, At, B0); PG8_MMA(0, 1, At, B1); PG8_BAR; PG8_SCHED;
            PG8_LDA(At, 0, 1); PG8_STAGE(PG8_SB(0, 0), b2, voffB); PG8_STAGE(PG8_SB(0, 1), b2 + hstep, voffB); PG8_STAGE(PG8_SA(0, 0), a2, voffA);
            PG8_WAIT_V(8); PG8_WAIT_L(0); PG8_BAR; PG8_MMA(1, 0, At, B0); PG8_MMA(1, 1, At, B1); PG8_BAR; PG8_SCHED;
            PG8_LDB(B0, 1, 0); PG8_LDB(B1, 1, 1); PG8_SCHED; PG8_LDA(At, 1, 0); PG8_STAGE(PG8_SA(0, 1), a2 + hstep, voffA);
            PG8_WAIT_V(8); PG8_WAIT_L(0); PG8_BAR; PG8_MMA(0, 0, At, B0); PG8_MMA(0, 1, At, B1); PG8_BAR; PG8_SCHED;
            PG8_LDA(At, 1, 1); PG8_STAGE(PG8_SB(1, 0), b3, voffB); PG8_STAGE(PG8_SB(1, 1), b3 + hstep, voffB); PG8_STAGE(PG8_SA(1, 0), a3, voffA);
            PG8_WAIT_V(8); PG8_WAIT_L(0); PG8_BAR; PG8_MMA(1, 0, At, B0); PG8_MMA(1, 1, At, B1); PG8_BAR; PG8_SCHED;
            } else {
            PG8_LDB(B0, 0, 0); PG8_SCHED; PG8_LDA(At, 0, 0); PG8_STAGE(PG8_SA(1, 1), a1 + hstep, voffA);
            PG8_WAIT_L(8); PG8_BAR; PG8_WAIT_L(0); PG8_MMA(0, 0, At, B0); PG8_BAR; PG8_SCHED;
            PG8_LDB(B1, 0, 1); PG8_STAGE(PG8_SB(0, 0), b2, voffB);
            PG8_BAR; PG8_WAIT_L(0); PG8_MMA(0, 1, At, B1); PG8_BAR;
            PG8_LDA(At, 0, 1); PG8_STAGE(PG8_SA(0, 0), a2, voffA);
            PG8_BAR; PG8_WAIT_L(0); PG8_MMA(1, 0, At, B0); PG8_BAR; PG8_SCHED;
            PG8_STAGE(PG8_SB(0, 1), b2 + hstep, voffB);
            PG8_WAIT_V(6); PG8_BAR; PG8_MMA(1, 1, At, B1); PG8_BAR;
            PG8_LDB(B0, 1, 0); PG8_SCHED; PG8_LDA(At, 1, 0); PG8_STAGE(PG8_SA(0, 1), a2 + hstep, voffA);
            PG8_WAIT_L(8); PG8_BAR; PG8_WAIT_L(0); PG8_MMA(0, 0, At, B0); PG8_BAR; PG8_SCHED;
            PG8_LDB(B1, 1, 1); PG8_STAGE(PG8_SB(1, 0), b3, voffB);
            PG8_BAR; PG8_WAIT_L(0); PG8_MMA(0, 1, At, B1); PG8_BAR;
            PG8_LDA(At, 1, 1); PG8_STAGE(PG8_SA(1, 0), a3, voffA);
            PG8_BAR; PG8_WAIT_L(0); PG8_MMA(1, 0, At, B0); PG8_BAR; PG8_SCHED;
            PG8_STAGE(PG8_SB(1, 1), b3 + hstep, voffB);
            PG8_WAIT_V(6); PG8_BAR; PG8_MMA(1, 1, At, B1); PG8_BAR;
            }
        }
        if constexpr (ALIGN_EPI) { if (wr == 0) PG8_BAR; }
        if constexpr (!Epi::AFTER_DRAIN) { E(acc, cur, wr, wc, fr, fq); S.done(cur); }
        if (!has_next) break;
#pragma unroll
        for (int a = 0; a < 2; ++a)
#pragma unroll
            for (int b = 0; b < 2; ++b)
#pragma unroll
                for (int m = 0; m < 4; ++m)
#pragma unroll
                    for (int n = 0; n < 2; ++n) acc[a][b][m][n] = (f32x4){0.f, 0.f, 0.f, 0.f};
        cur = nxt; cA = nA; cB = nB; ++ui;
        if constexpr (ALIGN_EPI) { if (wr == 1) PG8_BAR; }
    }
    PG8_WAIT_V(0);
    if constexpr (!ALIGN_EPI) { if (wr == 0) PG8_BAR; }
    PG8_BAR;
    if constexpr (Epi::AFTER_DRAIN) { E.fused(acc, cur, wr, wc, fr, fq, lds, wid, lane); S.done(cur); }
#undef PG8_SA
#undef PG8_SB
#undef PG8_STAGE
#undef PG8_LDA
#undef PG8_LDB
#undef PG8_MMA
#undef PG8_WAIT_V
#undef PG8_WAIT_L
#undef PG8_BAR
#undef PG8_SCHED
}
}

namespace mk {
#define LAS __attribute__((address_space(3)))
#define GAS __attribute__((address_space(1)))
using pg8::bf16_t; using pg8::f32x4; using pg8::u32x4; using pg8::Unit;
typedef short bf16x8 __attribute__((ext_vector_type(8)));
typedef float f32x16 __attribute__((ext_vector_type(16)));
typedef unsigned u32x2 __attribute__((ext_vector_type(2)));
typedef float f32x2_t __attribute__((ext_vector_type(2)));
typedef __bf16 bf16x2_t __attribute__((ext_vector_type(2)));

constexpr int DM = 1024, SEQ = 4096, MP = 65536, PAST = 1024, MS = 512, MT = MP + MS, SLEN = 1088, DBATCH = 8, KR = MP + DBATCH * SLEN, DFF = 2816;
constexpr float LOG2E = 1.4426950408889634f;
constexpr float QS_D = 0.125f * LOG2E;
constexpr float QS_M = 0.07216878364870322f * LOG2E;
constexpr float EPS = 1e-6f;
constexpr float LAM_INIT = 0.2f;

constexpr size_t O_Y = 0, O_DKP = 67633152, O_DVP = 101187584, O_CKVP = 134742016, O_KRP = 143130624, O_CONVP = 147324928,
                 O_DKS = 147415040, O_DVS = 147677184, O_CKVS = 147939328, O_KRS = 148004864, O_CONVS = 148037632, O_TOTAL = 148082688;

constexpr size_t al(size_t x) { return (x + 255) & ~(size_t)255; }
constexpr size_t WS_BAR = 0, WS_BAR_BYTES = 16384;
constexpr size_t WS_ROPE = 16384;
constexpr size_t WS_WIN = al(WS_ROPE + 4096 * 64 * 4);
constexpr size_t WS_WQB = al(WS_WIN + 2048 * 1024 * 2);
constexpr size_t WS_WKVB = al(WS_WQB + 768 * 256 * 2);
constexpr size_t WS_WOUT = al(WS_WKVB + 1024 * 128 * 2);
constexpr size_t WS_WUP = al(WS_WOUT + 1024 * 1024 * 2);
constexpr size_t WS_WDN = al(WS_WUP + 5632 * 1024 * 2);
constexpr size_t WS_RSQ = al(WS_WDN + 1024 * 2816 * 2);
constexpr size_t WS_RSQ2 = al(WS_RSQ + (size_t)66048 * 4);
constexpr size_t WS_RSQQ = al(WS_RSQ2 + (size_t)66048 * 4);
constexpr size_t WS_ACT = al(WS_RSQQ + (size_t)66048 * 4);
constexpr size_t WS_BIG = al(WS_ACT + (size_t)MT * 1024 * 2);
constexpr size_t WS_QD = WS_BIG;
constexpr size_t WS_KD = al(WS_QD + (size_t)MT * 512 * 2);
constexpr size_t WS_VTD = al(WS_KD + (size_t)KR * 512 * 2);
constexpr size_t WS_CQRAW = al(WS_VTD + (size_t)KR * 512 * 2);
constexpr size_t WS_CKVRAW = al(WS_CQRAW + (size_t)MT * 256 * 4);
constexpr size_t WS_CQ = al(WS_CKVRAW + (size_t)MT * 128 * 4);
constexpr size_t WS_CKV = al(WS_CQ + (size_t)MT * 256 * 2);
constexpr size_t WS_QM = al(WS_CKV + (size_t)KR * 128 * 2);
constexpr size_t WS_KM = al(WS_QM + (size_t)MT * 768 * 2);
constexpr size_t WS_VTM = al(WS_KM + (size_t)KR * 768 * 2);
constexpr size_t WS_ATT_END = al(WS_VTM + (size_t)KR * 512 * 2);
constexpr size_t WS_U = WS_BIG;
constexpr size_t WS_GS0 = al(WS_U + (size_t)MT * DFF * 2);
constexpr size_t WS_GS1 = al(WS_GS0 + (size_t)(MT / 64) * 2 * DFF * 4);
constexpr size_t WS_FFN_END = al(WS_GS1 + (size_t)(MT / 64) * 2 * DFF * 4);
constexpr size_t WS_H2 = WS_FFN_END;
constexpr size_t WS_H2_END = al(WS_H2 + (size_t)MT * 1024 * 2);
constexpr size_t WS_O0 = WS_ATT_END;
constexpr size_t WS_O0_END = al(WS_O0 + (size_t)256 * 64 * 512 * 4);
constexpr size_t WS_NEED = WS_O0_END > WS_H2_END ? WS_O0_END : WS_H2_END;

constexpr int LDS_BYTES = 147456;

struct Params { const float* in[25]; float* out; unsigned char* ws; };
constexpr int PARAM_OFF = 131072 + 1024;
struct PTab {
    LAS unsigned char* l;
    __device__ __forceinline__ unsigned long long ld(int k) const {
        const unsigned long long v = *(volatile LAS unsigned long long*)(l + PARAM_OFF + 8 * k);
        const unsigned lo = __builtin_amdgcn_readfirstlane((unsigned)v), hi = __builtin_amdgcn_readfirstlane((unsigned)(v >> 32));
        return ((unsigned long long)hi << 32) | lo;
    }
    __device__ __forceinline__ const float* in(int k) const { return (const float*)(const GAS float*)ld(k); }
    __device__ __forceinline__ float* out() const { return (float*)(GAS float*)ld(25); }
    __device__ __forceinline__ unsigned char* ws() const { return (unsigned char*)(GAS unsigned char*)ld(26); }
};

__device__ __forceinline__ unsigned pk2(float lo, float hi) { f32x2_t v = {lo, hi}; bf16x2_t b = __builtin_convertvector(v, bf16x2_t); return __builtin_bit_cast(unsigned, b); }
__device__ __forceinline__ bf16_t f2bf(float f) { return (bf16_t)(pk2(f, 0.f) & 0xffffu); }
__device__ __forceinline__ float bflo(unsigned w) { return __uint_as_float(w << 16); }
__device__ __forceinline__ float bfhi(unsigned w) { return __uint_as_float(w & 0xffff0000u); }
__device__ __forceinline__ float wave_sum(float v) {
#pragma unroll
    for (int o = 1; o < 64; o <<= 1) v += __shfl_xor(v, o);
    return v;
}
__device__ __forceinline__ int phase_tid(int wid_s) {
    int l; asm volatile("v_mbcnt_lo_u32_b32 %0, -1, 0\n\tv_mbcnt_hi_u32_b32 %0, -1, %0" : "=v"(l)); return wid_s * 64 + l;
}
__device__ __forceinline__ int permk(int k) { return (k & ~12) | ((k & 4) << 1) | ((k & 8) >> 1); }
__device__ __forceinline__ void tok_row(int r, int& pos, int& kr, int& kl, int& len) {
    if (r < MP) { pos = r & 4095; kr = r; kl = pos; len = SEQ; }
    else { const int j = r - MP, b = j >> 6, t = j & 63; pos = PAST + t; kl = PAST + t; kr = MP + b * SLEN + kl; len = SLEN; }
}
__device__ __forceinline__ void key_row(int kr, int& kl, int& len) {
    if (kr < MP) { kl = kr & 4095; len = SEQ; }
    else { const int j = kr - MP, b = j / SLEN; kl = j - b * SLEN; len = SLEN; }
}
__device__ __forceinline__ float* out_row(float* out, int r, size_t op, size_t os, int w) {
    return r < MP ? out + op + (size_t)r * w : out + os + (size_t)(r - MP) * w;
}
__device__ __forceinline__ u32x4 pack8(f32x4 a, f32x4 b) { u32x4 w; w.x = pk2(a[0], a[1]); w.y = pk2(a[2], a[3]); w.z = pk2(b[0], b[1]); w.w = pk2(b[2], b[3]); return w; }

struct EpiIn {
    static constexpr bool PERM = true, AFTER_DRAIN = false;
    float* out; bf16_t *qd, *kd, *vtd, *km; float *cqraw, *ckvraw; const float* rope; int novt; bf16_t* cq; const float* gq; float* rsqq;
    __device__ __forceinline__ void operator()(const f32x4 (&acc)[2][2][4][2], const Unit& u, int wr, int wc, int fr, int fq) const {
        const int pn = u.pn;
        const bool do_rope = (pn < 4) || (pn == 7 && wc == 2);
#pragma unroll
        for (int ai = 0; ai < 2; ++ai)
#pragma unroll
            for (int m = 0; m < 4; ++m) {
                const int r = u.pm * 256 + ai * 128 + wr * 64 + m * 16 + fr;
                int pos, kr, kl, len; tok_row(r, pos, kr, kl, len);
                if (do_rope) {
                    const float* cs = rope + pos * 64 + 8 * fq;
                    const f32x4 c0 = *(const f32x4*)cs, c1 = *(const f32x4*)(cs + 4), s0 = *(const f32x4*)(cs + 32), s1 = *(const f32x4*)(cs + 36);
                    const f32x4 x10 = acc[ai][0][m][0], x11 = acc[ai][0][m][1], x20 = acc[ai][1][m][0], x21 = acc[ai][1][m][1];
                    f32x4 a0 = x10 * c0 - x20 * s0, a1 = x11 * c1 - x21 * s1, b0 = x20 * c0 + x10 * s0, b1 = x21 * c1 + x11 * s1;
                    if (pn < 2) {
                        const int g = 4 * pn + wc;
                        bf16_t* d = qd + (size_t)r * 512 + 64 * g + 8 * fq;
                        *(u32x4*)d = pack8(a0 * QS_D, a1 * QS_D); *(u32x4*)(d + 32) = pack8(b0 * QS_D, b1 * QS_D);
                    } else if (pn < 4) {
                        const int g = 4 * (pn - 2) + wc;
                        float* o = out_row(out, r, O_DKP, O_DKS, 512) + 64 * g + 8 * fq;
                        *(f32x4*)o = a0; *(f32x4*)(o + 4) = a1; *(f32x4*)(o + 32) = b0; *(f32x4*)(o + 36) = b1;
                        bf16_t* d = kd + (size_t)kr * 512 + 64 * g + 8 * fq;
                        *(u32x4*)d = pack8(a0, a1); *(u32x4*)(d + 32) = pack8(b0, b1);
                    } else {
                        float* o = out_row(out, r, O_KRP, O_KRS, 64) + 8 * fq;
                        *(f32x4*)o = a0; *(f32x4*)(o + 4) = a1; *(f32x4*)(o + 32) = b0; *(f32x4*)(o + 36) = b1;
                        const u32x4 wa = pack8(a0, a1), wb = pack8(b0, b1);
#pragma unroll
                        for (int hh = 0; hh < 4; ++hh) { bf16_t* d = km + (size_t)kr * 768 + hh * 192 + 128 + 8 * fq; *(u32x4*)d = wa; *(u32x4*)(d + 32) = wb; }
                    }
                } else if (pn < 6) {
                    const int g = 4 * (pn - 4) + wc;
                    float* o = out_row(out, r, O_DVP, O_DVS, 512) + 64 * g + 8 * fq;
                    const bool odd = (fr & 1) != 0;
                    bf16_t* vb = vtd + (size_t)(kr - kl) * 512 + permk(kl & ~1);
#pragma unroll
                    for (int bj = 0; bj < 2; ++bj) {
                        *(f32x4*)(o + 32 * bj) = acc[ai][bj][m][0]; *(f32x4*)(o + 32 * bj + 4) = acc[ai][bj][m][1];
                        const f32x4 mine = odd ? acc[ai][bj][m][1] : acc[ai][bj][m][0], send = odd ? acc[ai][bj][m][0] : acc[ai][bj][m][1];
#pragma unroll
                        for (int e = 0; e < 4; ++e) {
                            const float recv = __shfl_xor(send[e], 1);
                            const int col = 64 * g + 32 * bj + 8 * fq + (odd ? 4 : 0) + e;
                            if (!novt) *(unsigned*)(vb + (size_t)col * len) = odd ? pk2(recv, mine[e]) : pk2(mine[e], recv);
                        }
                    }
                } else if (pn == 6) {
                    const int c = 64 * wc + 8 * fq; float ss = 0.f;
#pragma unroll
                    for (int bj = 0; bj < 2; ++bj) {
                        const f32x4 y0 = acc[ai][bj][m][0], y1 = acc[ai][bj][m][1];
                        const f32x4 g0 = *(const f32x4*)(gq + c + 32 * bj), g1 = *(const f32x4*)(gq + c + 32 * bj + 4);
                        *(u32x4*)(cq + (size_t)r * 256 + c + 32 * bj) = pack8(y0 * g0, y1 * g1);
                        ss += (y0[0] * y0[0] + y0[1] * y0[1]) + (y0[2] * y0[2] + y0[3] * y0[3]) + (y1[0] * y1[0] + y1[1] * y1[1]) + (y1[2] * y1[2] + y1[3] * y1[3]);
                    }
                    ss += __shfl_xor(ss, 16); ss += __shfl_xor(ss, 32);
                    if (fq == 0) atomicAdd(rsqq + r, ss);
                } else if (wc < 2) {
                    float* o = ckvraw + (size_t)r * 128 + 64 * wc + 8 * fq;
#pragma unroll
                    for (int bj = 0; bj < 2; ++bj) { *(f32x4*)(o + 32 * bj) = acc[ai][bj][m][0]; *(f32x4*)(o + 32 * bj + 4) = acc[ai][bj][m][1]; }
                }
                asm volatile("" ::: "memory");
            }
    }
};

struct EpiQm {
    static constexpr bool PERM = true, AFTER_DRAIN = false;
    bf16_t* qm; const float* rope; const float* rsqq;
    __device__ __forceinline__ void operator()(const f32x4 (&acc)[2][2][4][2], const Unit& u, int wr, int wc, int fr_in, int fq_in) const {
        int fr = fr_in, fq = fq_in; asm volatile("" : "+v"(fr), "+v"(fq));
        const int pn = u.pn;
#pragma unroll
        for (int ai = 0; ai < 2; ++ai)
#pragma unroll
            for (int m = 0; m < 4; ++m) {
                const int r = u.pm * 256 + ai * 128 + wr * 64 + m * 16 + fr;
                const float qs = QS_M * rsqrtf(rsqq[r] * (1.f / 256.f) + EPS);
                if (pn < 2) {
#pragma unroll
                    for (int bj = 0; bj < 2; ++bj) {
                        bf16_t* d = qm + (size_t)r * 768 + (2 * pn + bj) * 192 + 32 * wc + 8 * fq;
                        *(u32x4*)d = pack8(acc[ai][bj][m][0] * qs, acc[ai][bj][m][1] * qs);
                    }
                } else {
                    int pos, kr, kl, len; tok_row(r, pos, kr, kl, len);
                    const float* cs = rope + pos * 64 + 8 * fq;
                    const f32x4 c0 = *(const f32x4*)cs, c1 = *(const f32x4*)(cs + 4), s0 = *(const f32x4*)(cs + 32), s1 = *(const f32x4*)(cs + 36);
                    const f32x4 x10 = acc[ai][0][m][0], x11 = acc[ai][0][m][1], x20 = acc[ai][1][m][0], x21 = acc[ai][1][m][1];
                    f32x4 a0 = x10 * c0 - x20 * s0, a1 = x11 * c1 - x21 * s1, b0 = x20 * c0 + x10 * s0, b1 = x21 * c1 + x11 * s1;
                    bf16_t* d = qm + (size_t)r * 768 + wc * 192 + 128 + 8 * fq;
                    *(u32x4*)d = pack8(a0 * qs, a1 * qs); *(u32x4*)(d + 32) = pack8(b0 * qs, b1 * qs);
                }
                asm volatile("" ::: "memory");
            }
    }
};

struct EpiKv {
    static constexpr bool PERM = true, AFTER_DRAIN = false;
    bf16_t *km, *vtm;
    __device__ __forceinline__ void operator()(const f32x4 (&acc)[2][2][4][2], const Unit& u, int wr, int wc, int fr, int fq) const {
        const int hd = u.pn;
#pragma unroll
        for (int ai = 0; ai < 2; ++ai)
#pragma unroll
            for (int m = 0; m < 4; ++m) {
                const int kr = u.pm * 256 + ai * 128 + wr * 64 + m * 16 + fr;
                int kl, len; key_row(kr, kl, len);
                bf16_t* d = km + (size_t)kr * 768 + hd * 192 + 32 * wc + 8 * fq;
                *(u32x4*)d = pack8(acc[ai][0][m][0], acc[ai][0][m][1]);
                const bool odd = (fr & 1) != 0;
                bf16_t* vb = vtm + (size_t)(kr - kl) * 512 + (size_t)(hd * 128) * len + permk(kl & ~1);
                const f32x4 mine = odd ? acc[ai][1][m][1] : acc[ai][1][m][0], send = odd ? acc[ai][1][m][0] : acc[ai][1][m][1];
#pragma unroll
                for (int e = 0; e < 4; ++e) {
                    const float recv = __shfl_xor(send[e], 1);
                    const int dv = 32 * wc + 8 * fq + (odd ? 4 : 0) + e;
                    *(unsigned*)(vb + (size_t)dv * len) = odd ? pk2(recv, mine[e]) : pk2(mine[e], recv);
                }
            }
    }
};

struct EpiOut {
    static constexpr bool PERM = true, AFTER_DRAIN = false;
    const float* xp; const float* xs; bf16_t* h2; const float* gain; float* rowsq;
    __device__ __forceinline__ void operator()(const f32x4 (&acc)[2][2][4][2], const Unit& u, int wr, int wc, int fr, int fq) const {
#pragma unroll
        for (int ai = 0; ai < 2; ++ai)
#pragma unroll
            for (int m = 0; m < 4; ++m) {
                const int r = u.pm * 256 + ai * 128 + wr * 64 + m * 16 + fr;
                const float* x = r < MP ? xp + (size_t)r * 1024 : xs + (size_t)(r - MP) * 1024;
                float ss = 0.f;
#pragma unroll
                for (int bj = 0; bj < 2; ++bj) {
                    const int c = u.pn * 256 + 128 * bj + 32 * wc + 8 * fq;
                    const f32x4 r0 = __builtin_nontemporal_load((const f32x4*)(x + c)), r1 = __builtin_nontemporal_load((const f32x4*)(x + c + 4));
                    const f32x4 y0 = r0 + acc[ai][bj][m][0], y1 = r1 + acc[ai][bj][m][1];
                    const f32x4 g0 = *(const f32x4*)(gain + c), g1 = *(const f32x4*)(gain + c + 4);
                    *(u32x4*)(h2 + (size_t)r * 1024 + c) = pack8(y0 * g0, y1 * g1);
                    ss += (y0[0] * y0[0] + y0[1] * y0[1]) + (y0[2] * y0[2] + y0[3] * y0[3]) + (y1[0] * y1[0] + y1[1] * y1[1]) + (y1[2] * y1[2] + y1[3] * y1[3]);
                }
                ss += __shfl_xor(ss, 16); ss += __shfl_xor(ss, 32);
                if (fq == 0) atomicAdd(rowsq + r, ss);
                asm volatile("" ::: "memory");
            }
    }
};

struct EpiDown {
    static constexpr bool PERM = true, AFTER_DRAIN = false;
    const bf16_t* h2; const float* gain; bf16_t* yb; float* rowsq; int row0;
    __device__ __forceinline__ void operator()(const f32x4 (&acc)[2][2][4][2], const Unit& u, int wr, int wc, int fr, int fq) const {
        f32x4 gi[2][2];
#pragma unroll
        for (int bj = 0; bj < 2; ++bj) { const int c = u.pn * 256 + 128 * bj + 32 * wc + 8 * fq;
#pragma unroll
            for (int n = 0; n < 2; ++n) { const f32x4 g = *(const f32x4*)(gain + c + 4 * n); gi[bj][n] = (f32x4){1.f / g[0], 1.f / g[1], 1.f / g[2], 1.f / g[3]}; } }
#pragma unroll
        for (int ai = 0; ai < 2; ++ai)
#pragma unroll
            for (int m = 0; m < 4; ++m) {
                const int r = row0 + u.pm * 256 + ai * 128 + wr * 64 + m * 16 + fr;
                float ss = 0.f;
#pragma unroll
                for (int bj = 0; bj < 2; ++bj) {
                    const int c = u.pn * 256 + 128 * bj + 32 * wc + 8 * fq;
                    const u32x4 hw = *(const u32x4*)(h2 + (size_t)r * 1024 + c);
                    const f32x4 y0 = (f32x4){bflo(hw.x), bfhi(hw.x), bflo(hw.y), bfhi(hw.y)} * gi[bj][0] + acc[ai][bj][m][0], y1 = (f32x4){bflo(hw.z), bfhi(hw.z), bflo(hw.w), bfhi(hw.w)} * gi[bj][1] + acc[ai][bj][m][1];
                    *(u32x4*)(yb + (size_t)r * 1024 + c) = pack8(y0, y1);
                    ss += (y0[0] * y0[0] + y0[1] * y0[1]) + (y0[2] * y0[2] + y0[3] * y0[3]) + (y1[0] * y1[0] + y1[1] * y1[1]) + (y1[2] * y1[2] + y1[3] * y1[3]);
                }
                ss += __shfl_xor(ss, 16); ss += __shfl_xor(ss, 32);
                if (fq == 0) atomicAdd(rowsq + r, ss);
                asm volatile("" ::: "memory");
            }
    }
};

struct EpiUp {
    static constexpr bool PERM = true, AFTER_DRAIN = false;
    bf16_t* A; float *gs0, *gs1; const float *wconv, *bconv; float* out; const float* rowsq;
    __device__ __forceinline__ void operator()(const f32x4 (&acc)[2][2][4][2], const Unit& u, int wr, int wc, int fr, int fq) const {
        const int ch0 = 128 * u.pn + 32 * wc + 8 * fq;
        const int lane = fr + 16 * fq, src1 = (lane & 48) | ((fr + 15) & 15), src2 = (lane & 48) | ((fr + 14) & 15);
        float rs[2][4];
#pragma unroll
        for (int ai = 0; ai < 2; ++ai)
#pragma unroll
            for (int m = 0; m < 4; ++m) rs[ai][m] = rsqrtf(rowsq[u.pm * 256 + ai * 128 + wr * 64 + m * 16 + fr] * (1.f / 1024.f) + EPS);
#pragma unroll
        for (int n = 0; n < 2; ++n) {
            const int ch = ch0 + 4 * n;
            const f32x4 w0 = *(const f32x4*)(wconv + ch), w1 = *(const f32x4*)(wconv + DFF + ch), w2 = *(const f32x4*)(wconv + 2 * DFF + ch), bb = *(const f32x4*)(bconv + ch);
#pragma unroll
            for (int ai = 0; ai < 2; ++ai) {
                f32x4 pr1 = {0.f, 0.f, 0.f, 0.f}, pr2 = {0.f, 0.f, 0.f, 0.f};
#pragma unroll
                for (int m = 0; m < 4; ++m) {
                    const int r = u.pm * 256 + ai * 128 + wr * 64 + m * 16 + fr;
                    const f32x4 g = acc[ai][1][m][n] * rs[ai][m], uu = acc[ai][0][m][n] * rs[ai][m];
                    f32x4 R1, R2;
#pragma unroll
                    for (int e = 0; e < 4; ++e) { R1[e] = __shfl(g[e], src1); R2[e] = __shfl(g[e], src2); }
                    const f32x4 g1 = fr >= 1 ? R1 : pr1, g2 = fr >= 2 ? R2 : pr2;
                    pr1 = R1; pr2 = R2;
                    const f32x4 cv = bb + w0 * g2 + w1 * g1 + w2 * g;
                    f32x4 a;
#pragma unroll
                    for (int e = 0; e < 4; ++e) a[e] = cv[e] * __builtin_amdgcn_rcpf(1.f + __builtin_amdgcn_exp2f(-LOG2E * cv[e])) * uu[e];
                    const bool fix = (m == 0) && (fr < 2);
                    if (fix) a = uu;
                    u32x2 w; w.x = pk2(a[0], a[1]); w.y = pk2(a[2], a[3]);
                    *(u32x2*)(A + (size_t)r * DFF + ch) = w;
                    if (fix) *(f32x4*)(gs0 + (size_t)((r >> 6) * 2 + fr) * DFF + ch) = g;
                    if (m == 3 && fr >= 14) {
                        *(f32x4*)(gs1 + (size_t)((r >> 6) * 2 + (fr - 14)) * DFF + ch) = g;
                        if (r < MP) { if ((r & 4095) >= 4094) *(f32x4*)(out + O_CONVP + (size_t)((r >> 12) * 2 + (fr - 14)) * DFF + ch) = g; }
                        else *(f32x4*)(out + O_CONVS + (size_t)(((r - MP) >> 6) * 2 + (fr - 14)) * DFF + ch) = g;
                    }
                }
            }
        }
    }
};

constexpr int VPB = 144;
constexpr int ATT_KBYTES = 64 * (192 * 2 + 16);
constexpr int ATT_VBYTES = 128 * VPB;
constexpr int ATT_VOFF = 2 * ATT_KBYTES;
#define MFMA32(a, b, c) __builtin_amdgcn_mfma_f32_32x32x16_bf16((a), (b), (c), 0, 0, 0)

template <int DQK> __device__ __forceinline__ void att_load(const bf16_t* Kb, int kpitch, const bf16_t* Vb, int len, int kt, int tid, u32x4 (&kreg)[DQK / 64], u32x4 (&vreg)[2]) {
    constexpr int CPR = DQK / 8;
#pragma unroll
    for (int i = 0; i < DQK / 64; ++i) { const int p = tid + 512 * i, row = p / CPR, cp = p % CPR; kreg[i] = *(const u32x4*)(Kb + (size_t)(kt * 64 + row) * kpitch + cp * 8); }
#pragma unroll
    for (int i = 0; i < 2; ++i) { const int p = tid + 512 * i, row = p >> 3, cp = p & 7; vreg[i] = *(const u32x4*)(Vb + (size_t)row * len + kt * 64 + cp * 8); }
}
template <int DQK> __device__ __forceinline__ void att_store(LAS unsigned char* kbuf, LAS unsigned char* vbuf, int tid, const u32x4 (&kreg)[DQK / 64], const u32x4 (&vreg)[2]) {
    constexpr int CPR = DQK / 8, KP = DQK * 2 + 16;
#pragma unroll
    for (int i = 0; i < DQK / 64; ++i) { const int p = tid + 512 * i, row = p / CPR, cp = p % CPR; *(LAS u32x4*)(kbuf + row * KP + cp * 16) = kreg[i]; }
#pragma unroll
    for (int i = 0; i < 2; ++i) { const int p = tid + 512 * i, row = p >> 3, cp = p & 7; *(LAS u32x4*)(vbuf + row * VPB + cp * 16) = vreg[i]; }
}
template <int GS, int VAR> __device__ __forceinline__ void att_pv(f32x16 (&O)[4], const LAS unsigned char* vb, const bf16x8 (&pf)[4]) {
    bf16x8 va[2][GS];
    constexpr int NG = 16 / GS;
#pragma unroll
    for (int j = 0; j < GS; ++j) va[0][j] = *(const LAS bf16x8*)(vb + (j >> 2) * 32 * VPB + (j & 3) * 32);
#pragma unroll
    for (int g = 0; g < NG; ++g) {
        if (g + 1 < NG) {
#pragma unroll
            for (int j = 0; j < GS; ++j) { const int f = (g + 1) * GS + j; va[(g + 1) & 1][j] = *(const LAS bf16x8*)(vb + (f >> 2) * 32 * VPB + (f & 3) * 32); }
        }
#pragma unroll
        for (int j = 0; j < GS; ++j) { const int f = g * GS + j;
            if (VAR == 4) O[f >> 2][f & 3] += __builtin_bit_cast(f32x4, va[g & 1][j])[0] + __builtin_bit_cast(f32x4, pf[f & 3])[1];
            else O[f >> 2] = MFMA32(va[g & 1][j], pf[f & 3], O[f >> 2]); }
        __builtin_amdgcn_sched_barrier(0);
    }
}

template <int DQK, int VAR> __device__ __forceinline__ void att_tile(LAS unsigned char* lds, int kt, int mylast, int grp, bool& pend, int vs_prev, int vs_cur, int lane_off, int r, int h,
                                                            const bf16x8 (&qf)[DQK / 16], f32x16 (&O)[4], bf16x8 (&pf)[4], float& mrun, float& lrun) {
    constexpr int NS = DQK / 16, KP = DQK * 2 + 16;
    if (pend) { att_pv<(DQK == 64) ? 4 : 2, VAR>(O, lds + ATT_VOFF + vs_prev * ATT_VBYTES + lane_off, pf); pend = false; }
    if (kt <= mylast) {
        f32x16 S0, S1;
#pragma unroll
        for (int i = 0; i < 16; ++i) { S0[i] = 0.f; S1[i] = 0.f; }
        const LAS unsigned char* kb = lds + (kt & 1) * ATT_KBYTES + r * KP + h * 16;
        bf16x8 ka[3][2];
        ka[0][0] = *(const LAS bf16x8*)(kb); ka[0][1] = *(const LAS bf16x8*)(kb + 32 * KP);
        ka[1][0] = *(const LAS bf16x8*)(kb + 32); ka[1][1] = *(const LAS bf16x8*)(kb + 32 * KP + 32);
#pragma unroll
        for (int s = 0; s < NS; ++s) {
            if (s + 2 < NS) { ka[(s + 2) % 3][0] = *(const LAS bf16x8*)(kb + (s + 2) * 32); ka[(s + 2) % 3][1] = *(const LAS bf16x8*)(kb + 32 * KP + (s + 2) * 32); }
            if (VAR == 4) { S0[s & 15] += __builtin_bit_cast(f32x4, ka[s % 3][0])[0] * __builtin_bit_cast(f32x4, qf[s])[1]; S1[s & 15] += __builtin_bit_cast(f32x4, ka[s % 3][1])[2]; }
            else { S0 = MFMA32(ka[s % 3][0], qf[s], S0); S1 = MFMA32(ka[s % 3][1], qf[s], S1); }
            __builtin_amdgcn_sched_barrier(0);
        }
        if (VAR != 5) {
        float mx = S0[0];
#pragma unroll
        for (int i = 1; i < 16; ++i) mx = fmaxf(mx, S0[i]);
#pragma unroll
        for (int i = 0; i < 16; ++i) mx = fmaxf(mx, S1[i]);
        mx = fmaxf(mx, __shfl_xor(mx, 32));
        const float mn = fmaxf(mrun, mx), alpha = __builtin_amdgcn_exp2f(mrun - mn);
        const bool grew = __builtin_amdgcn_ballot_w64(mn > mrun) != 0ull;
        mrun = mn;
        float ps = 0.f;
#pragma unroll
        for (int i = 0; i < 16; ++i) { S0[i] = (VAR == 2) ? (S0[i] - mn) : __builtin_amdgcn_exp2f(S0[i] - mn); ps += S0[i]; }
#pragma unroll
        for (int i = 0; i < 16; ++i) { S1[i] = (VAR == 2) ? (S1[i] - mn) : __builtin_amdgcn_exp2f(S1[i] - mn); ps += S1[i]; }
        lrun = lrun * alpha + ps;
        if (grew) {
#pragma unroll
            for (int db = 0; db < 4; ++db) O[db] = O[db] * alpha;
        }
        } else lrun += S0[0];
        { u32x4 w;
          w.x = pk2(S0[0], S0[1]); w.y = pk2(S0[2], S0[3]); w.z = pk2(S0[4], S0[5]); w.w = pk2(S0[6], S0[7]); pf[0] = __builtin_bit_cast(bf16x8, w);
          w.x = pk2(S0[8], S0[9]); w.y = pk2(S0[10], S0[11]); w.z = pk2(S0[12], S0[13]); w.w = pk2(S0[14], S0[15]); pf[1] = __builtin_bit_cast(bf16x8, w);
          w.x = pk2(S1[0], S1[1]); w.y = pk2(S1[2], S1[3]); w.z = pk2(S1[4], S1[5]); w.w = pk2(S1[6], S1[7]); pf[2] = __builtin_bit_cast(bf16x8, w);
          w.x = pk2(S1[8], S1[9]); w.y = pk2(S1[10], S1[11]); w.z = pk2(S1[12], S1[13]); w.w = pk2(S1[14], S1[15]); pf[3] = __builtin_bit_cast(bf16x8, w); }
        if (grp == 0) att_pv<(DQK == 64) ? 4 : 2, VAR>(O, lds + ATT_VOFF + vs_cur * ATT_VBYTES + lane_off, pf);
        else pend = true;
    }
}

template <int DQK, int VAR> __device__ __forceinline__ void att_tile_fused(LAS unsigned char* lds, int kt, int mylast, bool& pend, int vs_prev, int vs_cur, int lane_off, int r, int h,
                                                                 const bf16x8 (&qf)[DQK / 16], f32x16 (&O)[4], bf16x8 (&pf)[4], float& mrun, float& lrun, float& alpha_p, bool& grew_p) {
    constexpr int KP = DQK * 2 + 16, NS = DQK / 16;
    if (grew_p) {
#pragma unroll
        for (int db = 0; db < 4; ++db) O[db] = O[db] * alpha_p;
        grew_p = false;
    }
    if (kt > mylast) {
        if (pend) { att_pv<4, VAR>(O, lds + ATT_VOFF + vs_prev * ATT_VBYTES + lane_off, pf); pend = false; }
        return;
    }
    f32x16 S0, S1;
#pragma unroll
    for (int i = 0; i < 16; ++i) { S0[i] = 0.f; S1[i] = 0.f; }
    const LAS unsigned char* kb = lds + (kt & 1) * ATT_KBYTES + r * KP + h * 16;
    bf16x8 ka[2][2];
    ka[0][0] = *(const LAS bf16x8*)(kb); ka[0][1] = *(const LAS bf16x8*)(kb + 32 * KP);
#pragma unroll
    for (int s = 0; s < NS; ++s) {
        if (s + 1 < NS) { ka[(s + 1) & 1][0] = *(const LAS bf16x8*)(kb + (s + 1) * 32); ka[(s + 1) & 1][1] = *(const LAS bf16x8*)(kb + 32 * KP + (s + 1) * 32); }
        S0 = MFMA32(ka[s & 1][0], qf[s], S0); S1 = MFMA32(ka[s & 1][1], qf[s], S1);
        __builtin_amdgcn_sched_barrier(0);
    }
    const LAS unsigned char* vb = lds + ATT_VOFF + (pend ? vs_prev : vs_cur) * ATT_VBYTES + lane_off;
    bf16x8 va[2][4];
#pragma unroll
    for (int js = 0; js < 4; ++js) va[0][js] = *(const LAS bf16x8*)(vb + js * 32);
    float mx = S0[0];
#pragma unroll
    for (int i = 1; i < 16; ++i) mx = fmaxf(mx, S0[i]);
#pragma unroll
    for (int i = 0; i < 16; ++i) mx = fmaxf(mx, S1[i]);
    mx = fmaxf(mx, __shfl_xor(mx, 32));
    const float mn = fmaxf(mrun, mx), alpha = __builtin_amdgcn_exp2f(mrun - mn);
    const bool grew = __builtin_amdgcn_ballot_w64(mn > mrun) != 0ull;
    mrun = mn;
    float ps = 0.f;
    u32x4 w0, w1, w2, w3;
    __builtin_amdgcn_sched_barrier(0);
#pragma unroll
    for (int db = 0; db < 4; ++db) {
        if (db < 3) {
#pragma unroll
            for (int js = 0; js < 4; ++js) va[(db + 1) & 1][js] = *(const LAS bf16x8*)(vb + (db + 1) * 32 * VPB + js * 32);
        }
#pragma unroll
        for (int js = 0; js < 4; ++js) {
            const int c = db * 4 + js;
            O[db] = MFMA32(va[db & 1][js], pf[js], O[db]);
            S0[c] = __builtin_amdgcn_exp2f(S0[c] - mn); S1[c] = __builtin_amdgcn_exp2f(S1[c] - mn); ps += S0[c] + S1[c];
            if (c & 1) {
                const unsigned a = pk2(S0[c - 1], S0[c]), b = pk2(S1[c - 1], S1[c]);
                const int q = c >> 1;
                if (q == 0) { w0.x = a; w2.x = b; } else if (q == 1) { w0.y = a; w2.y = b; } else if (q == 2) { w0.z = a; w2.z = b; } else if (q == 3) { w0.w = a; w2.w = b; }
                else if (q == 4) { w1.x = a; w3.x = b; } else if (q == 5) { w1.y = a; w3.y = b; } else if (q == 6) { w1.z = a; w3.z = b; } else { w1.w = a; w3.w = b; }
            }
            __builtin_amdgcn_sched_barrier(0);
        }
    }
    lrun = lrun * alpha + ps;
    alpha_p = alpha; grew_p = grew;
    pf[0] = __builtin_bit_cast(bf16x8, w0); pf[1] = __builtin_bit_cast(bf16x8, w1); pf[2] = __builtin_bit_cast(bf16x8, w2); pf[3] = __builtin_bit_cast(bf16x8, w3);
    pend = true;
}

template <int DQK, int VAR> __device__ __forceinline__ void attn_core(LAS unsigned char* lds, const bf16_t* Qrow, const bf16_t* Kb, int kpitch, const bf16_t* Vb, int len,
                                                             int ntiles, int mylast, int grp_in, f32x16 (&O)[4], int tid_in, int r_in, int h_in) {
    constexpr int NS = DQK / 16;
    constexpr bool PF2 = (DQK == 64);
    int tid = tid_in; asm volatile("" : "+v"(tid));
    const int r = tid & 31, h = (tid >> 5) & 1;
    const int grp = 0;
#define ATT_TILE(KT) do { if constexpr (DQK == 64 && VAR != 4 && VAR != 5) att_tile_fused<DQK, VAR>(lds, (KT), mylast, pend, vs_prev, vs_cur, lane_off, r, h, qf, O, pf, mrun, lrun, alpha_p, grew_p); \
        else att_tile<DQK, VAR>(lds, (KT), mylast, grp, pend, vs_prev, vs_cur, lane_off, r, h, qf, O, pf, mrun, lrun); } while (0)
    bf16x8 qf[NS];
#pragma unroll
    for (int s = 0; s < NS; ++s) qf[s] = (mylast >= 0) ? *(const bf16x8*)(Qrow + 16 * s + 8 * h) : (bf16x8){0, 0, 0, 0, 0, 0, 0, 0};
#pragma unroll
    for (int db = 0; db < 4; ++db)
#pragma unroll
        for (int i = 0; i < 16; ++i) O[db][i] = 0.f;
    float mrun = -1e30f, lrun = 0.f;
    bf16x8 pf[4];
#pragma unroll
    for (int j = 0; j < 4; ++j) pf[j] = (bf16x8){0, 0, 0, 0, 0, 0, 0, 0};
    int vs_prev = 2, vs_cur = 0, vs_next = 1;
    bool pend = false; float alpha_p = 1.f; bool grew_p = false;
    const int lane_off = r * VPB + h * 16;
    if constexpr (PF2) {
        u32x4 kA[DQK / 64], vA[2], kB[DQK / 64], vB[2];
        att_load<DQK>(Kb, kpitch, Vb, len, 0, tid, kA, vA);
        att_store<DQK>(lds, lds + ATT_VOFF, tid, kA, vA);
        if (VAR != 3 && ntiles > 1) att_load<DQK>(Kb, kpitch, Vb, len, 1, tid, kB, vB);
        __syncthreads();
        for (int kt = 0; kt < ntiles; kt += 2) {
            if (VAR != 3 && kt + 2 < ntiles) att_load<DQK>(Kb, kpitch, Vb, len, kt + 2, tid, kA, vA);
            ATT_TILE(kt);
            if (VAR != 3 && kt + 1 < ntiles) att_store<DQK>(lds + ((kt + 1) & 1) * ATT_KBYTES, lds + ATT_VOFF + vs_next * ATT_VBYTES, tid, kB, vB);
            __syncthreads();
            vs_prev = vs_cur; vs_cur = vs_next; vs_next = (vs_next == 2) ? 0 : vs_next + 1;
            if (kt + 1 < ntiles) {
                if (VAR != 3 && kt + 3 < ntiles) att_load<DQK>(Kb, kpitch, Vb, len, kt + 3, tid, kB, vB);
                ATT_TILE(kt + 1);
                if (VAR != 3 && kt + 2 < ntiles) att_store<DQK>(lds + (kt & 1) * ATT_KBYTES, lds + ATT_VOFF + vs_next * ATT_VBYTES, tid, kA, vA);
                __syncthreads();
                vs_prev = vs_cur; vs_cur = vs_next; vs_next = (vs_next == 2) ? 0 : vs_next + 1;
            }
        }
    } else {
        u32x4 kreg[DQK / 64], vreg[2];
        att_load<DQK>(Kb, kpitch, Vb, len, 0, tid, kreg, vreg);
        att_store<DQK>(lds, lds + ATT_VOFF, tid, kreg, vreg);
        __syncthreads();
        for (int kt = 0; kt < ntiles; ++kt) {
            const bool more = (kt + 1 < ntiles);
            if (more) att_load<DQK>(Kb, kpitch, Vb, len, kt + 1, tid, kreg, vreg);
            ATT_TILE(kt);
            if (more) att_store<DQK>(lds + ((kt + 1) & 1) * ATT_KBYTES, lds + ATT_VOFF + vs_next * ATT_VBYTES, tid, kreg, vreg);
            __syncthreads();
            vs_prev = vs_cur; vs_cur = vs_next; vs_next = (vs_next == 2) ? 0 : vs_next + 1;
        }
    }
    if (grew_p) {
#pragma unroll
        for (int db = 0; db < 4; ++db) O[db] = O[db] * alpha_p;
    }
    if (pend) att_pv<(DQK == 64) ? 4 : 2, VAR>(O, lds + ATT_VOFF + vs_prev * ATT_VBYTES + lane_off, pf);
    __syncthreads();
    const float lt = lrun + __shfl_xor(lrun, 32);
    const float inv = lt > 0.f ? 1.0f / lt : 0.f;
#pragma unroll
    for (int db = 0; db < 4; ++db) O[db] = O[db] * inv;
}

template <int VAR> __device__ __forceinline__ void attn_phase(LAS unsigned char* lds, const PTab& P, const int wid_s) {
    const int tid_ = phase_tid(wid_s);
    const int tid = tid_, wave = __builtin_amdgcn_readfirstlane(tid >> 6), lane = tid & 63, r = lane & 31, h = lane >> 5;
    unsigned char* ws = P.ws();
    const bf16_t* qd = (const bf16_t*)(ws + WS_QD); const bf16_t* kd = (const bf16_t*)(ws + WS_KD); const bf16_t* vtd = (const bf16_t*)(ws + WS_VTD);
    const bf16_t* qm = (const bf16_t*)(ws + WS_QM); const bf16_t* km = (const bf16_t*)(ws + WS_KM); const bf16_t* vtm = (const bf16_t*)(ws + WS_VTM);
    bf16_t* mix = (bf16_t*)(ws + WS_ACT);
    const float d1 = wave_sum(P.in(9)[lane] * P.in(10)[lane]), d2 = wave_sum(P.in(11)[lane] * P.in(12)[lane]);
    const float lam = __expf(d1) - __expf(d2) + LAM_INIT;
    const float* gsub = P.in(13);
    const int grp = (wave ^ (wave >> 2)) & 1;
    const int G = gridDim.x, c = blockIdx.x;
    constexpr int NPI = 2048, NITEMS = NPI + 64;
    const bool xcd_order = (G == 256);
    const int rounds = xcd_order ? 9 : (NITEMS + G - 1) / G;
    for (int it = 0; it < rounds; ++it) {
        int hh, ntiles, mylast, qrow, kroff, len;
        if (xcd_order) {
            const int x = c & 7, j = c >> 3;
            if (it < 8) {
                hh = (it & 1) ? 4 + (it >> 1) : (it >> 1);
                const int seq = 2 * x + (j >> 4), qb = ((it >> 1) & 1) ? 15 - (j & 15) : (j & 15);
                ntiles = 4 * qb + 4; mylast = 4 * qb + (wave >> 1); qrow = seq * 4096 + qb * 256 + 32 * wave + r; kroff = seq * 4096; len = SEQ;
            } else {
                if (j >= 8) continue;
                hh = j;
                ntiles = 17; mylast = wave < 2 ? 16 : -1; qrow = MP + x * 64 + 32 * (wave & 1) + r; kroff = MP + x * SLEN; len = SLEN;
            }
        } else {
            const int item = it * G + ((it & 1) ? (G - 1 - c) : c);
            if (item >= NITEMS) continue;
            if (item < NPI) {
                const int qb = 15 - (item >> 7), rem = item & 127, seq = rem >> 3; hh = rem & 7;
                ntiles = 4 * qb + 4; mylast = 4 * qb + (wave >> 1); qrow = seq * 4096 + qb * 256 + 32 * wave + r; kroff = seq * 4096; len = SEQ;
            } else {
                const int j = item - NPI, b = j >> 3; hh = j & 7;
                ntiles = 17; mylast = wave < 2 ? 16 : -1; qrow = MP + b * 64 + 32 * (wave & 1) + r; kroff = MP + b * SLEN; len = SLEN;
            }
        }
        if (VAR != 0 && VAR != 6 && hh >= 4) continue;
        if (VAR == 6 && it < 8) continue;
        const bool wr_ok = (VAR == 0) || (lam == 123456.789f);
        f32x16 O[4];
        asm volatile("" : "+v"(qrow));
        if (hh < 4) {
            attn_core<64, VAR>(lds, qd + (size_t)qrow * 512 + (2 * hh) * 64, kd + (size_t)kroff * 512 + (2 * hh) * 64, 512, vtd + (size_t)kroff * 512 + (size_t)(hh * 128) * len, len, ntiles, mylast, grp, O, tid, r, h);
            f32x4* o0s = (f32x4*)((float*)(ws + WS_O0) + ((size_t)blockIdx.x * 512 + tid) * 64);
#pragma unroll
            for (int db = 0; db < 4; ++db)
#pragma unroll
                for (int g4 = 0; g4 < 4; ++g4) o0s[db * 4 + g4] = (f32x4){O[db][4 * g4], O[db][4 * g4 + 1], O[db][4 * g4 + 2], O[db][4 * g4 + 3]};
            asm volatile("" : "+v"(qrow) :: "memory");
            attn_core<64, VAR>(lds, qd + (size_t)qrow * 512 + (2 * hh + 1) * 64, kd + (size_t)kroff * 512 + (2 * hh + 1) * 64, 512, vtd + (size_t)kroff * 512 + (size_t)(hh * 128) * len, len, ntiles, mylast, grp, O, tid, r, h);
            asm volatile("" : "+v"(qrow));
            if (mylast >= 0 && wr_ok) {
                float ss = 0.f;
#pragma unroll
                for (int db = 0; db < 4; ++db)
#pragma unroll
                    for (int g4 = 0; g4 < 4; ++g4) { const f32x4 p0 = o0s[db * 4 + g4];
#pragma unroll
                        for (int e = 0; e < 4; ++e) { const float o = p0[e] - lam * O[db][4 * g4 + e]; O[db][4 * g4 + e] = o; ss += o * o; } }
                ss += __shfl_xor(ss, 32);
                const float rs = rsqrtf(ss * (1.f / 128.f) + EPS) * (1.f - LAM_INIT);
                bf16_t* d = mix + (size_t)qrow * 1024 + hh * 128;
#pragma unroll
                for (int db = 0; db < 4; ++db)
#pragma unroll
                    for (int g4 = 0; g4 < 4; ++g4) {
                        const int dv = 32 * db + 8 * g4 + 4 * h;
                        const f32x4 gv = *(const f32x4*)(gsub + dv);
                        u32x2 w; w.x = pk2(O[db][4 * g4] * rs * gv[0], O[db][4 * g4 + 1] * rs * gv[1]); w.y = pk2(O[db][4 * g4 + 2] * rs * gv[2], O[db][4 * g4 + 3] * rs * gv[3]);
                        *(u32x2*)(d + dv) = w;
                    }
            }
        } else {
            const int hm = hh - 4;
            attn_core<192, VAR>(lds, qm + (size_t)qrow * 768 + hm * 192, km + (size_t)kroff * 768 + hm * 192, 768, vtm + (size_t)kroff * 512 + (size_t)(hm * 128) * len, len, ntiles, mylast, grp, O, tid, r, h);
            asm volatile("" : "+v"(qrow));
            if (mylast >= 0 && wr_ok) {
                bf16_t* d = mix + (size_t)qrow * 1024 + 512 + hm * 128;
#pragma unroll
                for (int db = 0; db < 4; ++db)
#pragma unroll
                    for (int g4 = 0; g4 < 4; ++g4) {
                        const int dv = 32 * db + 8 * g4 + 4 * h;
                        u32x2 w; w.x = pk2(O[db][4 * g4], O[db][4 * g4 + 1]); w.y = pk2(O[db][4 * g4 + 2], O[db][4 * g4 + 3]);
                        *(u32x2*)(d + dv) = w;
                    }
            }
        }
    }
}

template <int MODE> __device__ __forceinline__ int wmap(int np) {
    if (MODE == 0) { const int pn = np >> 8, j = np & 255, bj = j >> 7, wc = (j >> 5) & 3, i = j & 31; const int n = 256 * pn + 64 * wc + 32 * bj + i; return n < 1984 ? n : -1; }
    if (MODE == 1) { const int pn = np >> 8, j = np & 255; if (pn < 2) return 192 * (2 * pn + (j >> 7)) + (j & 127); const int bj = j >> 7, wc = (j >> 5) & 3, i = j & 31; return 192 * wc + 128 + 32 * bj + i; }
    if (MODE == 3) { const int pn = np >> 8, j = np & 255, bj = j >> 7, jj = j & 127; return bj * DFF + 128 * pn + jj; }
    return np;
}
template <int MODE> __device__ __forceinline__ void conv_w(const float* W, int K, int N, bf16_t* Wt, int NP, LAS float* scr, int gw, int ngw, int lane) {
    const int nblk = NP / 32, nitems = (K / 64) * nblk;
    for (int it = gw; it < nitems; it += ngw) {
        const int kb = it / nblk, nb = it % nblk, k0 = 64 * kb, np0 = 32 * nb, n0 = wmap<MODE>(np0);
#pragma unroll 8
        for (int i = 0; i < 32; ++i) { const int kk = 2 * i + (lane >> 5); scr[kk * 33 + (lane & 31)] = n0 >= 0 ? W[(size_t)(k0 + kk) * N + n0 + (lane & 31)] : 0.f; }
        asm volatile("s_waitcnt lgkmcnt(0)" ::: "memory");
        const int c = lane & 7;
#pragma unroll
        for (int j = 0; j < 4; ++j) { const int n = (lane >> 3) + 8 * j; const LAS float* sp = scr + (8 * c) * 33 + n;
            u32x4 o; o.x = pk2(sp[0 * 33], sp[1 * 33]); o.y = pk2(sp[2 * 33], sp[3 * 33]); o.z = pk2(sp[4 * 33], sp[5 * 33]); o.w = pk2(sp[6 * 33], sp[7 * 33]);
            *(u32x4*)(Wt + (size_t)(np0 + n) * K + k0 + 8 * c) = o; }
        asm volatile("s_waitcnt lgkmcnt(0)" ::: "memory");
    }
}
template <bool OUT_BF16> __device__ __forceinline__ void rms4(const float* x0, const float* g, void* o0, int lane) {
    const f32x4* g4 = (const f32x4*)g; f32x4 v[4][4];
#pragma unroll
    for (int i = 0; i < 4; ++i)
#pragma unroll
        for (int j = 0; j < 4; ++j) v[i][j] = __builtin_nontemporal_load(&((const f32x4*)(x0 + (size_t)i * 1024))[64 * j + lane]);
#pragma unroll
    for (int i = 0; i < 4; ++i) {
        float s = 0.f;
#pragma unroll
        for (int j = 0; j < 4; ++j) s += (v[i][j][0] * v[i][j][0] + v[i][j][1] * v[i][j][1]) + (v[i][j][2] * v[i][j][2] + v[i][j][3] * v[i][j][3]);
        const float rstd = rsqrtf(wave_sum(s) * (1.f / 1024.f) + EPS);
#pragma unroll
        for (int j = 0; j < 4; ++j) {
            const f32x4 o = v[i][j] * rstd * g4[64 * j + lane];
            if (OUT_BF16) { u32x2 w; w.x = pk2(o[0], o[1]); w.y = pk2(o[2], o[3]); *(u32x2*)((bf16_t*)o0 + (size_t)i * 1024 + 256 * j + 4 * lane) = w; }
            else ((f32x4*)((float*)o0 + (size_t)i * 1024))[64 * j + lane] = o;
        }
    }
}

__device__ __forceinline__ void phase0(LAS unsigned char* lds, const PTab& P, const int wid_s) {
    const int tid_ = phase_tid(wid_s);
    const int tid = tid_, wave = tid >> 6, lane = tid & 63;
    const int gtid = blockIdx.x * 512 + tid, gth = gridDim.x * 512, gw = blockIdx.x * 8 + wave, ngw = gridDim.x * 8;
    unsigned char* ws = P.ws();
    LAS float* scr = (LAS float*)(lds + wave * 16384);
    conv_w<0>(P.in(8), 1024, 1984, (bf16_t*)(ws + WS_WIN), 2048, scr, gw, ngw, lane);
    conv_w<1>(P.in(15), 256, 768, (bf16_t*)(ws + WS_WQB), 768, scr, gw, ngw, lane);
    conv_w<2>(P.in(17), 128, 1024, (bf16_t*)(ws + WS_WKVB), 1024, scr, gw, ngw, lane);
    conv_w<2>(P.in(18), 1024, 1024, (bf16_t*)(ws + WS_WOUT), 1024, scr, gw, ngw, lane);
    conv_w<3>(P.in(20), 1024, 5632, (bf16_t*)(ws + WS_WUP), 5632, scr, gw, ngw, lane);
    conv_w<2>(P.in(23), 2816, 1024, (bf16_t*)(ws + WS_WDN), 1024, scr, gw, ngw, lane);
    float* rope = (float*)(ws + WS_ROPE);
    { float* rsq = (float*)(ws + WS_RSQ); float* rsq2 = (float*)(ws + WS_RSQ2); float* rsqq = (float*)(ws + WS_RSQQ); for (int it = gtid; it < MT; it += gth) { rsq[it] = 0.f; rsq2[it] = 0.f; rsqq[it] = 0.f; } }
    for (int it = gtid; it < 4096 * 32; it += gth) {
        const int pos = it >> 5, i = it & 31;
        const float inv = (float)pow(10000.0, -(double)i * 0.03125);
        const float ang = (float)pos * inv;
        double rev = (double)ang * 0.15915494309189535; rev -= rint(rev);
        const float fr = (float)rev;
        rope[pos * 64 + i] = __builtin_amdgcn_cosf(fr); rope[pos * 64 + 32 + i] = __builtin_amdgcn_sinf(fr);
    }
    bf16_t* H = (bf16_t*)(ws + WS_ACT);
    { const float* xp = P.in(0); const float* xs = P.in(1); const float* ga = P.in(7);
      for (int r = 4 * gw; r < MT; r += 4 * ngw) rms4<true>(r < MP ? xp + (size_t)r * 1024 : xs + (size_t)(r - MP) * 1024, ga, H + (size_t)r * 1024, lane); }
    const float* cdk = P.in(2); const float* cdv = P.in(3); const float* cckv = P.in(4); const float* ckr = P.in(5);
    bf16_t* kd = (bf16_t*)(ws + WS_KD); bf16_t* vtd = (bf16_t*)(ws + WS_VTD); bf16_t* ckv = (bf16_t*)(ws + WS_CKV); bf16_t* km = (bf16_t*)(ws + WS_KM);
    for (int it = gtid; it < DBATCH * PAST * 64; it += gth) {
        const int c8 = it & 63, bp = it >> 6, b = bp >> 10, p = bp & 1023;
        const f32x4* s = (const f32x4*)(cdk + (size_t)bp * 512 + c8 * 8);
        *(u32x4*)(kd + (size_t)(MP + b * SLEN + p) * 512 + c8 * 8) = pack8(s[0], s[1]);
    }
    for (int it = gtid; it < DBATCH * (PAST / 16) * 512; it += gth) {
        const int col = it & 511, pblk = (it >> 9) & 63, b = it >> 15;
        const float* src = cdv + ((size_t)(b * PAST + pblk * 16)) * 512 + col;
        float v[16];
#pragma unroll
        for (int j = 0; j < 16; ++j) v[j] = src[(size_t)j * 512];
        u32x4 o0, o1;
        o0.x = pk2(v[0], v[1]); o0.y = pk2(v[2], v[3]); o0.z = pk2(v[8], v[9]); o0.w = pk2(v[10], v[11]);
        o1.x = pk2(v[4], v[5]); o1.y = pk2(v[6], v[7]); o1.z = pk2(v[12], v[13]); o1.w = pk2(v[14], v[15]);
        bf16_t* d = vtd + (size_t)(MP + b * SLEN) * 512 + (size_t)col * SLEN + pblk * 16;
        *(u32x4*)d = o0; *(u32x4*)(d + 8) = o1;
    }
    for (int it = gtid; it < DBATCH * PAST * 16; it += gth) {
        const int c8 = it & 15, bp = it >> 4, b = bp >> 10, p = bp & 1023;
        const f32x4* s = (const f32x4*)(cckv + (size_t)bp * 128 + c8 * 8);
        *(u32x4*)(ckv + (size_t)(MP + b * SLEN + p) * 128 + c8 * 8) = pack8(s[0], s[1]);
    }
    for (int it = gtid; it < DBATCH * PAST * 8; it += gth) {
        const int c8 = it & 7, bp = it >> 3, b = bp >> 10, p = bp & 1023;
        const f32x4* s = (const f32x4*)(ckr + (size_t)bp * 64 + c8 * 8);
        const u32x4 w = pack8(s[0], s[1]);
#pragma unroll
        for (int hh = 0; hh < 4; ++hh) *(u32x4*)(km + (size_t)(MP + b * SLEN + p) * 768 + hh * 192 + 128 + c8 * 8) = w;
    }
}

__device__ __forceinline__ void phase_lnorm(const PTab& P, const int wid_s) {
    const int tid_ = phase_tid(wid_s);
    const int tid = tid_, wave = tid >> 6, lane = tid & 63, gw = blockIdx.x * 8 + wave, ngw = gridDim.x * 8;
    unsigned char* ws = P.ws(); float* outp = P.out();
    const float* ckvraw = (const float*)(ws + WS_CKVRAW);
    bf16_t* ckv = (bf16_t*)(ws + WS_CKV);
    const f32x2_t gk = ((const f32x2_t*)P.in(16))[lane];
    for (int r0 = 8 * gw; r0 < MT; r0 += 8 * ngw) {
        f32x2_t k[8];
#pragma unroll
        for (int i = 0; i < 8; ++i) k[i] = ((const f32x2_t*)(ckvraw + (size_t)(r0 + i) * 128))[lane];
#pragma unroll
        for (int i = 0; i < 8; ++i) {
            const int r = r0 + i;
            const float s2 = wave_sum(k[i][0] * k[i][0] + k[i][1] * k[i][1]);
            const float rstd2 = rsqrtf(s2 * (1.f / 128.f) + EPS);
            const f32x2_t ko = k[i] * rstd2 * gk;
            int pos, kr, kl, len; tok_row(r, pos, kr, kl, len);
            *(f32x2_t*)(out_row(outp, r, O_CKVP, O_CKVS, 128) + 2 * lane) = ko;
            *(unsigned*)(ckv + (size_t)kr * 128 + 2 * lane) = pk2(ko[0], ko[1]);
        }
    }
}

__device__ __forceinline__ void phase_norm2(const PTab& P, const int wid_s) {
    const int tid_ = phase_tid(wid_s);
    const int tid = tid_, wave = tid >> 6, lane = tid & 63, gw = blockIdx.x * 8 + wave, ngw = gridDim.x * 8;
    bf16_t* H = (bf16_t*)(P.ws() + WS_ACT); const float* x1 = P.out(); const float* gf = P.in(19);
    for (int r = 4 * gw; r < MT; r += 4 * ngw) rms4<true>(x1 + (size_t)r * 1024, gf, H + (size_t)r * 1024, lane);
}

__device__ __forceinline__ void phase_conv(const PTab& P, const int wid_s) {
    const int tid_ = phase_tid(wid_s);
    const int gtid = blockIdx.x * 512 + tid_, gth = gridDim.x * 512;
    unsigned char* ws = P.ws();
    bf16_t* A = (bf16_t*)(ws + WS_U); const float* gs0 = (const float*)(ws + WS_GS0); const float* gs1 = (const float*)(ws + WS_GS1);
    const float* wconv = P.in(21); const float* bconv = P.in(22); const float* st = P.in(6);
    constexpr int C4 = DFF / 4, NIT = (MT / 64) * 2 * C4;
    for (int it = gtid; it < NIT; it += gth) {
        const int c4 = it % C4, bq = it / C4, q = bq & 1, b = bq >> 1, ch = 4 * c4, r = 64 * b + q;
        const bool prompt = b < (MP / 64), start = prompt ? ((b & 63) == 0) : true;
        const f32x4 zero = {0.f, 0.f, 0.f, 0.f};
        f32x4 p0 = zero, p1 = zero;
        if (!start) { p0 = *(const f32x4*)(gs1 + (size_t)((b - 1) * 2 + 0) * DFF + ch); p1 = *(const f32x4*)(gs1 + (size_t)((b - 1) * 2 + 1) * DFF + ch); }
        else if (!prompt) { const int sb = b - MP / 64; p0 = *(const f32x4*)(st + (size_t)(sb * 2 + 0) * DFF + ch); p1 = *(const f32x4*)(st + (size_t)(sb * 2 + 1) * DFF + ch); }
        const f32x4 g = *(const f32x4*)(gs0 + (size_t)(b * 2 + q) * DFF + ch);
        f32x4 g1, g2;
        if (q == 0) { g1 = p1; g2 = p0; } else { g1 = *(const f32x4*)(gs0 + (size_t)(b * 2) * DFF + ch); g2 = p1; }
        const f32x4 w0 = *(const f32x4*)(wconv + ch), w1 = *(const f32x4*)(wconv + DFF + ch), w2 = *(const f32x4*)(wconv + 2 * DFF + ch), bb = *(const f32x4*)(bconv + ch);
        const f32x4 cv = bb + w0 * g2 + w1 * g1 + w2 * g;
        const u32x2 uw = *(const u32x2*)(A + (size_t)r * DFF + ch);
        const f32x4 uu = {bflo(uw.x), bfhi(uw.x), bflo(uw.y), bfhi(uw.y)};
        f32x4 a;
#pragma unroll
        for (int e = 0; e < 4; ++e) a[e] = cv[e] / (1.f + __expf(-cv[e])) * uu[e];
        u32x2 w; w.x = pk2(a[0], a[1]); w.y = pk2(a[2], a[3]);
        *(u32x2*)(A + (size_t)r * DFF + ch) = w;
    }
}

__device__ __forceinline__ void final_items4(const bf16_t* yb, const float* rsq, const float* gfin, float* outp, int first, int stride, int limit) {
    u32x4 w[4];
#pragma unroll
    for (int k = 0; k < 4; ++k) { const int it = first + k * stride; if (it < limit) w[k] = __builtin_nontemporal_load((const u32x4*)(yb + (size_t)it * 8)); }
#pragma unroll
    for (int k = 0; k < 4; ++k) { const int it = first + k * stride; if (it < limit) {
        const int r = it >> 7, c = (it & 127) * 8;
        const float rs = rsqrtf(rsq[r] * (1.f / 1024.f) + EPS);
        const f32x4 g0 = *(const f32x4*)(gfin + c), g1 = *(const f32x4*)(gfin + c + 4);
        const f32x4 y0 = (f32x4){bflo(w[k].x), bfhi(w[k].x), bflo(w[k].y), bfhi(w[k].y)} * rs * g0, y1 = (f32x4){bflo(w[k].z), bfhi(w[k].z), bflo(w[k].w), bfhi(w[k].w)} * rs * g1;
        __builtin_nontemporal_store(y0, (f32x4*)(outp + (size_t)it * 8)); __builtin_nontemporal_store(y1, (f32x4*)(outp + (size_t)it * 8 + 4)); } }
}
__device__ __forceinline__ void phase_final_prompt(LAS unsigned char* lds, const PTab& P, const int wid_s) {
    const int tid = phase_tid(wid_s);
    unsigned char* ws = P.ws();
    const bf16_t* yb = (const bf16_t*)(ws + WS_ACT); const float* rsq = (const float*)(ws + WS_RSQ2); const float* gfin = P.in(24); float* outp = P.out();
    unsigned* ctr = (unsigned*)ws + 3600;
    volatile LAS unsigned* slot = (volatile LAS unsigned*)(lds + PARAM_OFF + 272);
    constexpr int NCH = MP / 64, CH_ITEMS = 64 * 128;
    for (;;) {
        if (tid == 0) slot[0] = atomicAdd(ctr, 1u);
        __syncthreads();
        const unsigned idx = slot[0];
        __syncthreads();
        if (idx >= (unsigned)NCH) break;
        const int base = (int)idx * CH_ITEMS;
#pragma unroll 1
        for (int g = 0; g < 4; ++g) final_items4(yb, rsq, gfin, outp, base + tid + g * 2048, 512, base + CH_ITEMS);
    }
}
__device__ __forceinline__ void phase_final_sample(const PTab& P, const int wid_s) {
    const int tid_ = phase_tid(wid_s);
    const int gtid = blockIdx.x * 512 + tid_, gth = gridDim.x * 512;
    unsigned char* ws = P.ws();
    const bf16_t* yb = (const bf16_t*)(ws + WS_ACT); const float* rsq = (const float*)(ws + WS_RSQ2); const float* gfin = P.in(24); float* outp = P.out();
    for (int it0 = MP * 128 + gtid; it0 < MT * 128; it0 += 4 * gth) final_items4(yb, rsq, gfin, outp, it0, gth, MT * 128);
}

#define XB_TMO      128
#define XB_XCNT(j)  (256  + 64 * (j))
#define XB_XSUB(j)  (1280 + 64 * (j))
#define XB_XGEN(j)  (2304 + 64 * (j))
#define XB_TOP      3328
#define XB_TOPGEN   3392
#define XB_SPIN_CAP (1u << 18)
__device__ __forceinline__ unsigned xb_ld(unsigned* p)              { return __hip_atomic_load(p, __ATOMIC_RELAXED, __HIP_MEMORY_SCOPE_AGENT); }
__device__ __forceinline__ unsigned xb_add(unsigned* p, unsigned v) { return __hip_atomic_fetch_add(p, v, __ATOMIC_RELAXED, __HIP_MEMORY_SCOPE_AGENT); }
__device__ __forceinline__ unsigned xb_xcc_id() { return (unsigned)__builtin_amdgcn_s_getreg((3 << 11) | 20) & 0xFu; }
#define XB_SPIN(cond, bar) do { unsigned _sp = 0; while (cond) { __builtin_amdgcn_s_sleep(1); \
    if ((++_sp & 255u) == 0u) { if (xb_ld(&(bar)[XB_TMO])) break; if (_sp > XB_SPIN_CAP) { atomicAdd(&(bar)[XB_TMO], 1u); break; } } } } while (0)
__device__ __forceinline__ void xcd_barrier_complete(unsigned* bar, unsigned x, unsigned& nloc, unsigned& nx) {
    const unsigned G = gridDim.x;
    unsigned sum, cnt, mine, sp = 0u;
    for (;;) {
        sum = 0u; cnt = 0u; mine = 0u;
#pragma unroll
        for (unsigned j = 0; j < 16; ++j) { const unsigned c = xb_ld(&bar[XB_XCNT(j)]); sum += c; cnt += (c > 0u) ? 1u : 0u; mine = (j == x) ? c : mine; }
        if (sum == G) break;
        __builtin_amdgcn_s_sleep(1);
        if ((++sp & 255u) == 0u) { if (xb_ld(&bar[XB_TMO])) break; if (sp > XB_SPIN_CAP) { atomicAdd(&bar[XB_TMO], 1u); break; } }
    }
    nloc = mine > 0u ? mine : 1u; nx = cnt > 0u ? cnt : 1u;
}
__device__ __forceinline__ void xcd_barrier(unsigned* bar, const unsigned x, volatile LAS unsigned* st, const bool leader) {
    asm volatile("s_waitcnt vmcnt(0)" ::: "memory");
    __syncthreads();
    if (leader) {
        __builtin_amdgcn_s_waitcnt(0);
        unsigned nloc = st[0], nx = st[1];
        if (nloc == 0u) { xcd_barrier_complete(bar, x, nloc, nx); st[0] = nloc; st[1] = nx; }
        const unsigned old = xb_add(&bar[XB_XSUB(x)], 1u);
        const unsigned gen = old / nloc;
        if (old + 1u == (gen + 1u) * nloc) {
            __builtin_amdgcn_fence(__ATOMIC_RELEASE, "agent");
            asm volatile("s_waitcnt vmcnt(0)" ::: "memory");
            const unsigned og = xb_add(&bar[XB_TOP], 1u);
            const unsigned tg = og / nx;
            if (og + 1u == (tg + 1u) * nx) xb_add(&bar[XB_TOPGEN], 1u);
            else XB_SPIN(xb_ld(&bar[XB_TOPGEN]) == tg, bar);
            __builtin_amdgcn_fence(__ATOMIC_ACQUIRE, "agent");
            xb_add(&bar[XB_XGEN(x)], 1u);
            asm volatile("s_waitcnt vmcnt(0)" ::: "memory");
        } else {
            XB_SPIN(xb_ld(&bar[XB_XGEN(x)]) == gen, bar);
            __builtin_amdgcn_fence(__ATOMIC_ACQUIRE, "agent");
            asm volatile("s_waitcnt vmcnt(0)" ::: "memory");
        }
    }
    __syncthreads();
}

#ifndef MK_STOP
#define MK_STOP 99
#endif
#ifndef MK_MASK
#define MK_MASK 0xffff
#endif
#ifndef MK_DUP
#define MK_DUP 0
#endif
#ifndef MK_NOVT
#define MK_NOVT 0
#endif
#define PH(k) if ((MK_MASK >> (k)) & 1)
__global__ void __launch_bounds__(512, 2) fwd_kernel(Params KP) {
    extern __shared__ __attribute__((aligned(16))) unsigned char lds_raw[];
    LAS unsigned char* lds = (LAS unsigned char*)lds_raw;
    cg::grid_group grid = cg::this_grid();
    if (threadIdx.x == 0) {
        LAS unsigned long long* t = (LAS unsigned long long*)(lds + PARAM_OFF);
#pragma unroll
        for (int k = 0; k < 25; ++k) t[k] = (unsigned long long)KP.in[k];
        t[25] = (unsigned long long)KP.out; t[26] = (unsigned long long)KP.ws;
        ((volatile LAS unsigned*)(lds + PARAM_OFF + 256))[0] = 0u; ((volatile LAS unsigned*)(lds + PARAM_OFF + 256))[1] = 0u;
        (void)xb_add(&((unsigned*)KP.ws)[XB_XCNT(xb_xcc_id())], 1u);
    }
    __syncthreads();
    PTab P{lds};
    const int wid_s = __builtin_amdgcn_readfirstlane(threadIdx.x >> 6);
    const unsigned xcc = xb_xcc_id();
#define GRID_BAR() xcd_barrier((unsigned*)P.ws(), xcc, (volatile LAS unsigned*)(lds + PARAM_OFF + 256), phase_tid(wid_s) == 0)
    const int G = gridDim.x, c = blockIdx.x;
    PH(0) phase0(lds, P, wid_s);
    if (MK_DUP & 1) phase0(lds, P, wid_s);
    if (gridDim.x == 0x7fffffffu) grid.sync();
    GRID_BAR();
    if (MK_STOP <= 0) return;
    PH(1) {
        unsigned char* ws = P.ws();
        pg8::Gemm g{(const bf16_t*)(ws + WS_ACT), (const bf16_t*)(ws + WS_WIN), MT, 2048, 1024}; pg8::StaticOrder S; S.init(MT, 2048, G, c);
        EpiIn E{P.out(), (bf16_t*)(ws + WS_QD), (bf16_t*)(ws + WS_KD), (bf16_t*)(ws + WS_VTD), (bf16_t*)(ws + WS_KM), (float*)(ws + WS_CQRAW), (float*)(ws + WS_CKVRAW), (const float*)(ws + WS_ROPE), 0, (bf16_t*)(ws + WS_CQ), P.in(14), (float*)(ws + WS_RSQQ)};
        pg8::gemm_phase<EpiIn, pg8::StaticOrder, true, true>(lds, g, S, E, phase_tid(wid_s));
    }
    if (MK_DUP & (1 << 1)) {
        unsigned char* ws = P.ws();
        pg8::Gemm g{(const bf16_t*)(ws + WS_ACT), (const bf16_t*)(ws + WS_WIN), MT, 2048, 1024}; pg8::StaticOrder S; S.init(MT, 2048, G, c);
        EpiIn E{P.out(), (bf16_t*)(ws + WS_QD), (bf16_t*)(ws + WS_KD), (bf16_t*)(ws + WS_VTD), (bf16_t*)(ws + WS_KM), (float*)(ws + WS_CQRAW), (float*)(ws + WS_CKVRAW), (const float*)(ws + WS_ROPE), MK_NOVT, (bf16_t*)(ws + WS_CQ), P.in(14), (float*)(ws + WS_RSQQ)};
        pg8::gemm_phase<EpiIn, pg8::StaticOrder, true, true>(lds, g, S, E, phase_tid(wid_s));
    }
    GRID_BAR();
    if (MK_STOP <= 1) return;
    PH(2) phase_lnorm(P, wid_s);
    if (MK_DUP & 4) phase_lnorm(P, wid_s);
    GRID_BAR();
    if (MK_STOP <= 2) return;
    PH(3) {
        unsigned char* ws = P.ws();
        pg8::Gemm g{(const bf16_t*)(ws + WS_CQ), (const bf16_t*)(ws + WS_WQB), MT, 768, 256}; pg8::StaticOrder S; S.init(MT, 768, G, c);
        EpiQm E{(bf16_t*)(ws + WS_QM), (const float*)(ws + WS_ROPE), (const float*)(ws + WS_RSQQ)};
        pg8::gemm_phase<EpiQm, pg8::StaticOrder, true, true>(lds, g, S, E, phase_tid(wid_s));
    }
    if (MK_DUP & (1 << 3)) {
        unsigned char* ws = P.ws();
        pg8::Gemm g{(const bf16_t*)(ws + WS_CQ), (const bf16_t*)(ws + WS_WQB), MT, 768, 256}; pg8::StaticOrder S; S.init(MT, 768, G, c);
        EpiQm E{(bf16_t*)(ws + WS_QM), (const float*)(ws + WS_ROPE), (const float*)(ws + WS_RSQQ)};
        pg8::gemm_phase<EpiQm, pg8::StaticOrder, true, true>(lds, g, S, E, phase_tid(wid_s));
    }
    PH(4) {
        unsigned char* ws = P.ws();
        pg8::Gemm g{(const bf16_t*)(ws + WS_CKV), (const bf16_t*)(ws + WS_WKVB), KR, 1024, 128}; pg8::StaticOrder S; S.init(KR, 1024, G, c);
        EpiKv E{(bf16_t*)(ws + WS_KM), (bf16_t*)(ws + WS_VTM)};
        pg8::gemm_phase<EpiKv, pg8::StaticOrder, true, true>(lds, g, S, E, phase_tid(wid_s));
    }
    if (MK_DUP & (1 << 4)) {
        unsigned char* ws = P.ws();
        pg8::Gemm g{(const bf16_t*)(ws + WS_CKV), (const bf16_t*)(ws + WS_WKVB), KR, 1024, 128}; pg8::StaticOrder S; S.init(KR, 1024, G, c);
        EpiKv E{(bf16_t*)(ws + WS_KM), (bf16_t*)(ws + WS_VTM)};
        pg8::gemm_phase<EpiKv, pg8::StaticOrder, true, true>(lds, g, S, E, phase_tid(wid_s));
    }
    GRID_BAR();
    if (MK_STOP <= 3) return;
    PH(5) attn_phase<0>(lds, P, wid_s);
#ifdef MK_AVAR
    __syncthreads(); attn_phase<MK_AVAR>(lds, P, wid_s);
#endif
    GRID_BAR();
    if (MK_STOP <= 4) return;
    PH(6) {
        unsigned char* ws = P.ws();
        pg8::Gemm g{(const bf16_t*)(ws + WS_ACT), (const bf16_t*)(ws + WS_WOUT), MT, 1024, 1024}; pg8::StaticOrder S; S.init(MT, 1024, G, c);
        EpiOut E{P.in(0), P.in(1), (bf16_t*)(ws + WS_H2), P.in(19), (float*)(ws + WS_RSQ)};
        pg8::gemm_phase<EpiOut, pg8::StaticOrder, true, true>(lds, g, S, E, phase_tid(wid_s));
    }
    if (MK_DUP & (1 << 6)) {
        unsigned char* ws = P.ws();
        pg8::Gemm g{(const bf16_t*)(ws + WS_ACT), (const bf16_t*)(ws + WS_WOUT), MT, 1024, 1024}; pg8::StaticOrder S; S.init(MT, 1024, G, c);
        EpiOut E{P.in(0), P.in(1), (bf16_t*)(ws + WS_H2), P.in(19), (float*)(ws + WS_RSQ)};
        pg8::gemm_phase<EpiOut, pg8::StaticOrder, true, true>(lds, g, S, E, phase_tid(wid_s));
    }
    GRID_BAR();
    PH(8) {
        unsigned char* ws = P.ws();
        pg8::Gemm g{(const bf16_t*)(ws + WS_H2), (const bf16_t*)(ws + WS_WUP), MT, 5632, 1024}; pg8::StaticOrder S; S.init(MT, 5632, G, c);
        EpiUp E{(bf16_t*)(ws + WS_U), (float*)(ws + WS_GS0), (float*)(ws + WS_GS1), P.in(21), P.in(22), P.out(), (const float*)(ws + WS_RSQ)};
        pg8::gemm_phase<EpiUp, pg8::StaticOrder, true, true>(lds, g, S, E, phase_tid(wid_s));
    }
    if (MK_DUP & (1 << 8)) {
        unsigned char* ws = P.ws();
        pg8::Gemm g{(const bf16_t*)(ws + WS_H2), (const bf16_t*)(ws + WS_WUP), MT, 5632, 1024}; pg8::StaticOrder S; S.init(MT, 5632, G, c);
        EpiUp E{(bf16_t*)(ws + WS_U), (float*)(ws + WS_GS0), (float*)(ws + WS_GS1), P.in(21), P.in(22), P.out(), (const float*)(ws + WS_RSQ)};
        pg8::gemm_phase<EpiUp, pg8::StaticOrder, true, true>(lds, g, S, E, phase_tid(wid_s));
    }
    GRID_BAR();
    PH(9) phase_conv(P, wid_s);
    GRID_BAR();
    PH(10) {
        unsigned char* ws = P.ws();
        pg8::Gemm g{(const bf16_t*)(ws + WS_U), (const bf16_t*)(ws + WS_WDN), MP, 1024, 2816}; pg8::StaticOrder S; S.init(MP, 1024, G, c);
        EpiDown E{(const bf16_t*)(ws + WS_H2), P.in(19), (bf16_t*)(ws + WS_ACT), (float*)(ws + WS_RSQ2), 0};
        pg8::gemm_phase<EpiDown, pg8::StaticOrder, true, true>(lds, g, S, E, phase_tid(wid_s));
    }
    GRID_BAR();
    PH(11) {
        unsigned char* ws = P.ws();
        pg8::Gemm g{(const bf16_t*)(ws + WS_U) + (size_t)MP * 2816, (const bf16_t*)(ws + WS_WDN), MS, 1024, 2816}; pg8::StaticOrder S; S.init(MS, 1024, G, c);
        EpiDown E{(const bf16_t*)(ws + WS_H2), P.in(19), (bf16_t*)(ws + WS_ACT), (float*)(ws + WS_RSQ2), MP};
        pg8::gemm_phase<EpiDown, pg8::StaticOrder, true, true>(lds, g, S, E, phase_tid(wid_s));
    }
    PH(11) phase_final_prompt(lds, P, wid_s);
    GRID_BAR();
    PH(11) phase_final_sample(P, wid_s);
#ifdef MK_XSYNC
    for (int k = 0; k < MK_XSYNC; ++k) GRID_BAR();
#endif
}
}

extern "C" void kernel_launch(void* const* d_in, const int* in_sizes, int n_in, void* d_out, int out_size, void* d_ws, size_t ws_size, hipStream_t stream) {
    static int grid = 0;
    if (grid == 0) {
        if (n_in != 25 || (size_t)out_size != mk::O_TOTAL || ws_size < mk::WS_NEED) {
            fprintf(stderr, "kernel_launch: unexpected shapes (n_in %d, out %d, ws %zu, need %zu); nothing launched\n", n_in, out_size, ws_size, (size_t)mk::WS_NEED); grid = -1; return; }
        int dev = 0, cus = 0, per_cu = 0;
        hipGetDevice(&dev);
        hipDeviceGetAttribute(&cus, hipDeviceAttributeMultiprocessorCount, dev);
        hipFuncSetAttribute((const void*)mk::fwd_kernel, hipFuncAttributeMaxDynamicSharedMemorySize, mk::LDS_BYTES);
        hipOccupancyMaxActiveBlocksPerMultiprocessor(&per_cu, (const void*)mk::fwd_kernel, 512, mk::LDS_BYTES);
        if (per_cu < 1) { fprintf(stderr, "kernel_launch: occupancy query says %d blocks per CU\n", per_cu); per_cu = 1; }
        (void)hipGetLastError();
        grid = cus < 256 ? cus : 256;
    }
    if (grid < 0) return;
    if (hipMemsetAsync(d_ws, 0, mk::WS_BAR_BYTES, stream) != hipSuccess) { fprintf(stderr, "kernel_launch: memset of the barrier words failed\n"); return; }
    mk::Params p{};
    for (int i = 0; i < 25; ++i) p.in[i] = (const float*)d_in[i];
    p.out = (float*)d_out; p.ws = (unsigned char*)d_ws;
    void* args[] = {&p};
    hipError_t e = hipLaunchCooperativeKernel((const void*)mk::fwd_kernel, dim3(grid), dim3(512), args, mk::LDS_BYTES, stream);
    if (e != hipSuccess) fprintf(stderr, "cooperative launch failed: %s (grid %d)\n", hipGetErrorString(e), grid);
}
```
